# Optimizing an MI355X kernel written in HIP

```python
import math
import jax, jax.numpy as jnp
from jax import lax
import numpy as np

D_MODEL = 1024
BATCH = 16
SEQ = 2048
DEPTH = 4

N_EVEN = (DEPTH + 1) // 2
N_ODD = DEPTH // 2
ROPE_THETA = 10000.0
BLOCK = 128
NORM_EPS = 1e-5

RET_HEADS = 8
RET_DK = D_MODEL // RET_HEADS
RET_DV = D_MODEL // RET_HEADS
RET_QK_WIDTH = RET_HEADS * RET_DK
RET_WIDTH = RET_HEADS * RET_DV

LRU_WIDTH = D_MODEL
LRU_BLOCKS = 8
LRU_BLOCK_DIM = LRU_WIDTH // LRU_BLOCKS
CONV_WIDTH = 4
LRU_C = 8.0

DIFF_HEADS = 8
DIFF_DH = D_MODEL // DIFF_HEADS
DIFF_DV = 2 * DIFF_DH
DIFF_QK_WIDTH = 2 * DIFF_HEADS * DIFF_DH
DIFF_WIDTH = DIFF_HEADS * DIFF_DV

EVEN_IN = 3 * RET_QK_WIDTH + RET_WIDTH + 2 * LRU_WIDTH
EVEN_MIX = RET_WIDTH + LRU_WIDTH
ODD_IN = 2 * DIFF_QK_WIDTH + 2 * DIFF_WIDTH
ODD_MIX = DIFF_WIDTH

DEEPNORM_ALPHA = (2.0 * DEPTH) ** 0.25
DEEPNORM_BETA = (8.0 * DEPTH) ** -0.25

kernel_name = "hybrid_retention_rglru_diffattn_deepnorm"


def rope(x, pos):
    half = x.shape[-1] // 2
    inv_freq = ROPE_THETA ** (-jnp.arange(half, dtype=jnp.float32) / half)
    ang = pos.astype(jnp.float32)[:, None] * inv_freq[None, :]
    cos = jnp.cos(ang)[:, None, :]
    sin = jnp.sin(ang)[:, None, :]
    x1 = x[..., :half].astype(jnp.float32)
    x2 = x[..., half:].astype(jnp.float32)
    return jnp.concatenate([x1 * cos - x2 * sin, x2 * cos + x1 * sin], axis=-1)


def layer_norm(x, g, b):
    x = x.astype(jnp.float32)
    mu = jnp.mean(x, axis=-1, keepdims=True)
    var = jnp.mean(jnp.square(x - mu), axis=-1, keepdims=True)
    return (x - mu) * lax.rsqrt(var + NORM_EPS) * g + b


def retention(q, k, v):
    B, S, H, dk = q.shape
    dv = v.shape[-1]
    N = S // BLOCK
    log_g = jnp.log(1.0 - 2.0 ** (-5.0 - jnp.arange(H, dtype=jnp.float32)))
    idx = jnp.arange(BLOCK, dtype=jnp.float32)
    rel = idx[:, None] - idx[None, :]
    decay = jnp.where(rel[None] >= 0, jnp.exp(log_g[:, None, None] * jnp.maximum(rel, 0.0)[None]), 0.0)
    qc = q.reshape(B, N, BLOCK, H, dk)
    kc = k.reshape(B, N, BLOCK, H, dk)
    vc = v.astype(jnp.float32).reshape(B, N, BLOCK, H, dv)
    scores = jnp.einsum('bnihd,bnjhd->bnhij', qc, kc) * decay
    intra = jnp.einsum('bnhij,bnjhe->bnihe', scores, vc)
    k_end = kc * jnp.exp(log_g[None, :] * (BLOCK - 1 - idx)[:, None])[:, :, None]
    kv = jnp.einsum('bnjhd,bnjhe->nbhde', k_end, vc)
    chunk_decay = jnp.exp(log_g * BLOCK)[None, :, None, None]

    def step(R, kv_n):
        return R * chunk_decay + kv_n, R

    _, R_prev = lax.scan(step, jnp.zeros((B, H, dk, dv), jnp.float32), kv)
    q_dec = qc * jnp.exp(log_g[None, :] * (idx + 1.0)[:, None])[:, :, None]
    cross = jnp.einsum('bnihd,nbhde->bnihe', q_dec, R_prev)
    return (intra + cross).reshape(B, S, H, dv)


def rg_lru_branch(xb, conv_w, conv_b, wa, ba, wx, bx, lam):
    B, S, W = xb.shape
    xb = xb.astype(jnp.float32)
    xc = lax.conv_general_dilated(
        xb, conv_w.astype(jnp.float32)[:, None, :], window_strides=(1,),
        padding=[(CONV_WIDTH - 1, 0)], dimension_numbers=('NWC', 'WIO', 'NWC'),
        feature_group_count=W) + conv_b
    xg = xc.reshape(B, S, LRU_BLOCKS, LRU_BLOCK_DIM)
    r = jax.nn.sigmoid(jnp.einsum('bsgi,gij->bsgj', xg, wa).reshape(B, S, W) + ba)
    i = jax.nn.sigmoid(jnp.einsum('bsgi,gij->bsgj', xg, wx).reshape(B, S, W) + bx)
    log_a = -LRU_C * r * jax.nn.softplus(-lam.astype(jnp.float32))
    a = jnp.exp(log_a)
    u = xc * i * jnp.sqrt(-jnp.expm1(2.0 * log_a))

    def combine(e1, e2):
        a1, b1 = e1
        a2, b2 = e2
        return a1 * a2, a2 * b1 + b2

    _, h = lax.associative_scan(combine, (a, u), axis=1)
    return h


def diff_attention(q, k, v, lam):
    B, S, H2, d = q.shape
    H = H2 // 2
    nb = S // BLOCK
    v = v.astype(jnp.float32)
    qb = q.reshape(B, nb, BLOCK, H2, d).transpose(1, 0, 2, 3, 4)
    kpos = jnp.arange(S)

    def one_block(args):
        qblk, start = args
        s = jnp.einsum('bqhd,bkhd->bhqk', qblk, k)
        qpos = start + jnp.arange(BLOCK)
        s = jnp.where((kpos[None, :] <= qpos[:, None])[None, None], s, -jnp.inf)
        p = jax.nn.softmax(s, axis=-1).reshape(B, H, 2, BLOCK, S)
        w = p[:, :, 0] - lam * p[:, :, 1]
        return jnp.einsum('bhqk,bkhe->bqhe', w, v)

    out = lax.map(one_block, (qb, jnp.arange(nb) * BLOCK))
    return out.transpose(1, 0, 2, 3, 4).reshape(B, S, H, 2 * d)


def even_layer(x, w_in, conv_w, conv_b, wa, ba, wx, bx, lam, gn_g, gn_b, w_out, pos):
    B, S, _ = x.shape
    proj = jnp.einsum('bsd,de->bse', x, w_in)
    q, k, v, g_ret, xb, g_lru = jnp.split(
        proj, [RET_QK_WIDTH, 2 * RET_QK_WIDTH, 2 * RET_QK_WIDTH + RET_WIDTH,
               2 * RET_QK_WIDTH + 2 * RET_WIDTH, 2 * RET_QK_WIDTH + 2 * RET_WIDTH + LRU_WIDTH], axis=-1)
    q = rope(q.reshape(B, S, RET_HEADS, RET_DK), pos)
    k = rope(k.reshape(B, S, RET_HEADS, RET_DK), pos) * (RET_DK ** -0.5)
    ret = retention(q, k, v.reshape(B, S, RET_HEADS, RET_DV))
    mu = jnp.mean(ret, axis=-1, keepdims=True)
    var = jnp.mean(jnp.square(ret - mu), axis=-1, keepdims=True)
    ret = ((ret - mu) * lax.rsqrt(var + NORM_EPS)).reshape(B, S, RET_WIDTH) * gn_g + gn_b
    ret = ret * jax.nn.silu(g_ret.astype(jnp.float32))
    lru = rg_lru_branch(xb, conv_w, conv_b, wa, ba, wx, bx, lam) * jax.nn.silu(g_lru.astype(jnp.float32))
    return jnp.einsum('bse,ed->bsd', jnp.concatenate([ret, lru], axis=-1), w_out)


def odd_layer(x, w_in, lq1, lk1, lq2, lk2, subln_g, w_out, pos, lambda_init):
    B, S, _ = x.shape
    proj = jnp.einsum('bsd,de->bse', x, w_in)
    q, k, v, g = jnp.split(proj, [DIFF_QK_WIDTH, 2 * DIFF_QK_WIDTH, 2 * DIFF_QK_WIDTH + DIFF_WIDTH], axis=-1)
    q = rope(q.reshape(B, S, 2 * DIFF_HEADS, DIFF_DH), pos) * (DIFF_DH ** -0.5)
    k = rope(k.reshape(B, S, 2 * DIFF_HEADS, DIFF_DH), pos)
    lam = (jnp.exp(jnp.sum(lq1.astype(jnp.float32) * lk1)) - jnp.exp(jnp.sum(lq2.astype(jnp.float32) * lk2))
           + lambda_init)
    out = diff_attention(q, k, v.reshape(B, S, DIFF_HEADS, DIFF_DV), lam)
    out = out * lax.rsqrt(jnp.mean(jnp.square(out), axis=-1, keepdims=True) + NORM_EPS) * subln_g
    out = (out * (1.0 - lambda_init)).reshape(B, S, DIFF_WIDTH) * jax.nn.silu(g.astype(jnp.float32))
    return jnp.einsum('bse,ed->bsd', out, w_out)


def setup_inputs(seed: int = 0) -> dict:
    key = jax.random.key(seed)
    ks = jax.random.split(key, 32)
    f32 = jnp.float32
    nrm = lambda k, shape, s: jax.random.normal(k, shape, f32) * s
    ev_scale = jnp.concatenate([jnp.ones((2 * RET_QK_WIDTH,), f32), jnp.full((RET_WIDTH,), DEEPNORM_BETA, f32),
                                jnp.ones((RET_WIDTH,), f32), jnp.full((LRU_WIDTH,), DEEPNORM_BETA, f32),
                                jnp.ones((LRU_WIDTH,), f32)])
    od_scale = jnp.concatenate([jnp.ones((2 * DIFF_QK_WIDTH,), f32), jnp.full((DIFF_WIDTH,), DEEPNORM_BETA, f32),
                                jnp.ones((DIFF_WIDTH,), f32)])
    u = jax.random.uniform(ks[8], (N_EVEN, LRU_WIDTH), f32, 0.9, 0.999)
    a0 = u ** (1.0 / LRU_C)
    return {
        "x": nrm(ks[0], (BATCH, SEQ, D_MODEL), 1.0),
        "ev_w_in": nrm(ks[1], (N_EVEN, D_MODEL, EVEN_IN), D_MODEL ** -0.5) * ev_scale,
        "ev_conv_w": nrm(ks[2], (N_EVEN, CONV_WIDTH, LRU_WIDTH), CONV_WIDTH ** -0.5),
        "ev_conv_b": nrm(ks[3], (N_EVEN, LRU_WIDTH), 0.01),
        "ev_gate_a_w": nrm(ks[4], (N_EVEN, LRU_BLOCKS, LRU_BLOCK_DIM, LRU_BLOCK_DIM), LRU_BLOCK_DIM ** -0.5),
        "ev_gate_a_b": nrm(ks[5], (N_EVEN, LRU_WIDTH), 0.01),
        "ev_gate_x_w": nrm(ks[6], (N_EVEN, LRU_BLOCKS, LRU_BLOCK_DIM, LRU_BLOCK_DIM), LRU_BLOCK_DIM ** -0.5),
        "ev_gate_x_b": nrm(ks[7], (N_EVEN, LRU_WIDTH), 0.01),
        "ev_lru_lambda": jnp.log(a0) - jnp.log1p(-a0),
        "ev_ret_gn_g": 1.0 + nrm(ks[9], (N_EVEN, RET_WIDTH), 0.02),
        "ev_ret_gn_b": nrm(ks[10], (N_EVEN, RET_WIDTH), 0.02),
        "ev_w_out": nrm(ks[11], (N_EVEN, EVEN_MIX, D_MODEL), EVEN_MIX ** -0.5 * DEEPNORM_BETA),
        "ev_ln_g": 1.0 + nrm(ks[12], (N_EVEN, D_MODEL), 0.02),
        "ev_ln_b": nrm(ks[13], (N_EVEN, D_MODEL), 0.02),
        "od_w_in": nrm(ks[14], (N_ODD, D_MODEL, ODD_IN), D_MODEL ** -0.5) * od_scale,
        "od_lambda_q1": nrm(ks[15], (N_ODD, DIFF_DH), 0.1),
        "od_lambda_k1": nrm(ks[16], (N_ODD, DIFF_DH), 0.1),
        "od_lambda_q2": nrm(ks[17], (N_ODD, DIFF_DH), 0.1),
        "od_lambda_k2": nrm(ks[18], (N_ODD, DIFF_DH), 0.1),
        "od_subln_g": 1.0 + nrm(ks[19], (N_ODD, DIFF_DV), 0.02),
        "od_w_out": nrm(ks[20], (N_ODD, ODD_MIX, D_MODEL), ODD_MIX ** -0.5 * DEEPNORM_BETA),
        "od_ln_g": 1.0 + nrm(ks[21], (N_ODD, D_MODEL), 0.02),
        "od_ln_b": nrm(ks[22], (N_ODD, D_MODEL), 0.02),
    }


def reference(x, ev_w_in, ev_conv_w, ev_conv_b, ev_gate_a_w, ev_gate_a_b, ev_gate_x_w, ev_gate_x_b,
              ev_lru_lambda, ev_ret_gn_g, ev_ret_gn_b, ev_w_out, ev_ln_g, ev_ln_b,
              od_w_in, od_lambda_q1, od_lambda_k1, od_lambda_q2, od_lambda_k2, od_subln_g, od_w_out,
              od_ln_g, od_ln_b):
    in_dtype = x.dtype
    pos = jnp.arange(x.shape[1], dtype=jnp.int32)
    h = x
    for l in range(DEPTH):
        j = l // 2
        if l % 2 == 0:
            y = even_layer(h, ev_w_in[j], ev_conv_w[j], ev_conv_b[j], ev_gate_a_w[j], ev_gate_a_b[j],
                           ev_gate_x_w[j], ev_gate_x_b[j], ev_lru_lambda[j], ev_ret_gn_g[j], ev_ret_gn_b[j],
                           ev_w_out[j], pos)
            h = layer_norm(DEEPNORM_ALPHA * h.astype(jnp.float32) + y, ev_ln_g[j], ev_ln_b[j])
        else:
            lambda_init = 0.8 - 0.6 * math.exp(-0.3 * l)
            y = odd_layer(h, od_w_in[j], od_lambda_q1[j], od_lambda_k1[j], od_lambda_q2[j], od_lambda_k2[j],
                          od_subln_g[j], od_w_out[j], pos, lambda_init)
            h = layer_norm(DEEPNORM_ALPHA * h.astype(jnp.float32) + y, od_ln_g[j], od_ln_b[j])
    return h.astype(in_dtype)
```

```cpp
#include <hip/hip_runtime.h>
#include <cstdio>
#include <cstdint>

#ifndef MK_SPLIT
#define MK_SPLIT 0
#endif

#define GAS __attribute__((address_space(1)))
#define LAS __attribute__((address_space(3)))
typedef unsigned short bf16;
typedef short bf16x8 __attribute__((ext_vector_type(8)));
typedef short s16x4 __attribute__((ext_vector_type(4)));
typedef float f32x4 __attribute__((ext_vector_type(4)));
typedef float f32x16 __attribute__((ext_vector_type(16)));
typedef unsigned u32x4 __attribute__((ext_vector_type(4)));
typedef unsigned u32x2 __attribute__((ext_vector_type(2)));

constexpr int BATCH = 16, SEQ = 2048, DM = 1024, MTOK = BATCH * SEQ;
constexpr int PP = 6144;
constexpr float DN_ALPHA = 1.6817928305074290f;
constexpr float NORM_EPS = 1e-5f;
constexpr float QK_SCALE = 0.08838834764831845f;
constexpr float LOG2E = 1.4426950408889634f;

constexpr size_t MiB = 1u << 20;
constexpr size_t WS_CTL = 0, CTL_ZERO_BYTES = 1 * MiB;
constexpr size_t WS_ROPE = 1 * MiB;
constexpr size_t WS_PAR = 2 * MiB;
constexpr size_t WS_WG = 3 * MiB;
constexpr size_t WS_WOUT = 4 * MiB;
constexpr size_t WS_WIN = 20 * MiB;
constexpr size_t WS_X16 = 36 * MiB;
constexpr size_t WS_P = 100 * MiB;
constexpr size_t WS_END = 484 * MiB;
constexpr int CW_BAR = 4096;

constexpr int LDS_BYTES = 147456;
constexpr int LDS_X = 131072;
constexpr int MISC_OFF = LDS_BYTES - 256;

typedef float f32x2_t __attribute__((ext_vector_type(2))); typedef __bf16 bf16x2_t __attribute__((ext_vector_type(2)));
__device__ __forceinline__ unsigned cvt_pk(float lo, float hi) { f32x2_t v = {lo, hi}; bf16x2_t b = __builtin_convertvector(v, bf16x2_t); return __builtin_bit_cast(unsigned, b); }
__device__ __forceinline__ float bf_lo(unsigned w) { return __uint_as_float(w << 16); }
__device__ __forceinline__ float bf_hi(unsigned w) { return __uint_as_float(w & 0xffff0000u); }
__device__ __forceinline__ float silu_f(float x) { return x * __builtin_amdgcn_rcpf(1.0f + __builtin_amdgcn_exp2f(-LOG2E * x)); }
__device__ __forceinline__ float sigmoid_f(float x) { return __builtin_amdgcn_rcpf(1.0f + __builtin_amdgcn_exp2f(-LOG2E * x)); }
__device__ __forceinline__ int crow(int r, int hi) { return (r & 3) + 8 * (r >> 2) + 4 * hi; }
#define LDS_WAIT() asm volatile("s_waitcnt lgkmcnt(0)" ::: "memory")
#define VM_WAIT() asm volatile("s_waitcnt vmcnt(0)" ::: "memory")

__device__ __forceinline__ unsigned off_a(unsigned row, unsigned ch) { return 2048u * (row >> 3) + 512u * (ch >> 2) + 64u * (row & 7) + 16u * ((ch & 3) ^ ((row >> 2) & 3)); }
__device__ __forceinline__ unsigned rr_base(int lane, int par) { const unsigned r = lane & 31, h = lane >> 5; return 2048u * (r >> 3) + 64u * (r & 7) + 16u * ((2u * par + h) ^ ((r >> 2) & 3)); }
__device__ __forceinline__ unsigned trn_base(int lane, int t) { const unsigned h = lane >> 5, blk = (lane >> 4) & 1, q = (lane & 15) >> 2, p = lane & 3;
    return 2048u * h + 64u * (4u * t + q) + 16u * ((2u * blk + (p >> 1)) ^ ((2u * h + t) & 3)) + 8u * (p & 1); }
__device__ __forceinline__ unsigned trp_base(int lane, int t) { const unsigned h = lane >> 5, blk = (lane >> 4) & 1, q = (lane & 15) >> 2, p = lane & 3;
    return 2048u * t + 64u * (4u * h + q) + 16u * ((2u * blk + (p >> 1)) ^ ((2u * t + h) & 3)) + 8u * (p & 1); }
typedef short v4i16_t __attribute__((ext_vector_type(4)));
__device__ __forceinline__ s16x4 vtr(const LAS unsigned char* p) { return __builtin_bit_cast(s16x4, __builtin_amdgcn_ds_read_tr16_b64_v4i16((LAS v4i16_t*)p)); }
__device__ __forceinline__ bf16x8 cat8(s16x4 a, s16x4 b) { return (bf16x8){a[0], a[1], a[2], a[3], b[0], b[1], b[2], b[3]}; }
__device__ __forceinline__ bf16x8 pack8f(const f32x16& x, int o) {
    u32x4 w = {cvt_pk(x[o + 0], x[o + 1]), cvt_pk(x[o + 2], x[o + 3]), cvt_pk(x[o + 4], x[o + 5]), cvt_pk(x[o + 6], x[o + 7])};
    return __builtin_bit_cast(bf16x8, w); }
__device__ __forceinline__ float swap32_max(float v) { auto rr = __builtin_amdgcn_permlane32_swap(__float_as_uint(v), __float_as_uint(v), false, false); return fmaxf(__uint_as_float(rr[0]), __uint_as_float(rr[1])); }
__device__ __forceinline__ float swap32_sum(float v) { auto rr = __builtin_amdgcn_permlane32_swap(__float_as_uint(v), __float_as_uint(v), false, false); return __uint_as_float(rr[0]) + __uint_as_float(rr[1]); }

namespace pg8 {
#define PG8_LAS __attribute__((address_space(3)))
typedef unsigned short bf16_t;
typedef short bf16x8 __attribute__((ext_vector_type(8)));
typedef float f32x4 __attribute__((ext_vector_type(4)));
typedef unsigned u32x4 __attribute__((ext_vector_type(4)));
constexpr int BM = 256, BK = 64, HALF = 128, HTB = HALF * BK * 2  , STAGE_BYTES = 8 * HTB, NXCD = 8, WGM = 8;

__host__ __device__ __forceinline__ int lds_byte(int r, int c) { const int st = (r >> 4) * 2 + (c >> 5), rr = r & 15, cc = c & 31, ob = rr * 64 + cc * 2; return st * 1024 + (ob ^ (((ob >> 9) & 1) << 5)); }
__host__ __device__ __forceinline__ void stage_rc(int b, int& R, int& C) { const int st = b / 1024, sb = b % 1024, swz = sb ^ (((sb >> 9) & 1) << 5); R = (st >> 1) * 16 + swz / 64; C = (st & 1) * 32 + (swz % 64) / 2; }
__host__ __device__ __forceinline__ int perm32(int rho) { const int n = rho >> 4, i = rho & 15; return 8 * (i >> 2) + 4 * n + (i & 3); }

struct Unit { int pm, pn; };
struct Gemm { const bf16_t* A; const bf16_t* Bt; int M, N, K, lda; };

struct StaticOrder {
    int nM, nN, nwg, G, c;
    __host__ __device__ void init(int M, int N, int G_, int c_) { nM = M / BM; nN = N / BM; nwg = nM * nN; G = G_; c = c_; }
    __host__ __device__ bool next(int i, Unit& u) const {
        const long L = (long)i * G + c; if (L >= nwg) return false;
        int wgid = (int)L; { const int q = nwg / NXCD, r = nwg % NXCD, xcd = wgid % NXCD, off = wgid / NXCD; wgid = (xcd < r ? xcd * (q + 1) : r * (q + 1) + (xcd - r) * q) + off; }
        const int nig = WGM * nN, gid = wgid / nig, fm = gid * WGM, gsz = (nM - fm) < WGM ? (nM - fm) : WGM;
        u.pm = fm + ((wgid % nig) % gsz); u.pn = (wgid % nig) / gsz; return true;
    }
    __device__ __forceinline__ void a_ready(const Unit&) const {}
    __device__ __forceinline__ void done(const Unit&) const {}
};

__device__ __forceinline__ unsigned cvt_pk_bf16(float lo, float hi) { return cvt_pk(lo, hi); }
typedef float f32x2 __attribute__((ext_vector_type(2)));
struct PanelStats {
    unsigned* xbuf;
    unsigned* cnt;
    unsigned* tmo;
    int ntn; float eps;
    unsigned code;
    __device__ __forceinline__ bool run(const f32x4 (&v)[2][2][4][2], const Unit& u, int wr, int wc, int fr, int fq, PG8_LAS unsigned char* lds, int wid, int lane) const {
        typedef float f32x2v __attribute__((ext_vector_type(2)));
        PG8_LAS f32x2v* P = (PG8_LAS f32x2v*)lds;
        PG8_LAS f32x2v* S = (PG8_LAS f32x2v*)(lds + 8192);
        PG8_LAS unsigned* flag = (PG8_LAS unsigned*)(lds + 8192 + 2048);
#pragma unroll
        for (int ai = 0; ai < 2; ++ai)
#pragma unroll
            for (int m = 0; m < 4; ++m) {
                float s = 0.f;
#pragma unroll
                for (int bj = 0; bj < 2; ++bj)
#pragma unroll
                    for (int n = 0; n < 2; ++n) { const f32x4 x = v[ai][bj][m][n]; s += (x[0] + x[1]) + (x[2] + x[3]); }
                s += __shfl_xor(s, 16); s += __shfl_xor(s, 32);
                const float mw = s * (1.0f / 64.0f); float q = 0.f;
#pragma unroll
                for (int bj = 0; bj < 2; ++bj)
#pragma unroll
                    for (int n = 0; n < 2; ++n) { const f32x4 d = v[ai][bj][m][n] - mw; q += (d[0] * d[0] + d[1] * d[1]) + (d[2] * d[2] + d[3] * d[3]); }
                q += __shfl_xor(q, 16); q += __shfl_xor(q, 32);
                if (fq == 0) P[(ai * HALF + wr * 64 + m * 16 + fr) * 4 + wc] = (f32x2v){mw, q};
            }
        asm volatile("s_waitcnt lgkmcnt(0)" ::: "memory"); __builtin_amdgcn_s_barrier(); asm volatile("" ::: "memory");
#if defined(BROKEN_EXCHANGE_NO_WAIT)
#warning BROKEN CONTROL BUILD: the row-statistics exchange does not wait; results are wrong by design
        if (blockIdx.x >= 64) { const long long t0_ = clock64(); while (clock64() - t0_ < 60000) __builtin_amdgcn_s_sleep(8); }
#endif
        const int row = wid * 32 + (lane & 31);
        if (lane < 32) {
            const f32x2v a = P[row * 4 + 0], b = P[row * 4 + 1], c = P[row * 4 + 2], d = P[row * 4 + 3];
            const float mt = (a.x + b.x + c.x + d.x) * 0.25f;
            const float da = a.x - mt, db = b.x - mt, dc = c.x - mt, dd = d.x - mt;
            const float m2 = (a.y + b.y) + (c.y + d.y) + 64.0f * ((da * da + db * db) + (dc * dc + dd * dd));
            unsigned long long* slot = (unsigned long long*)xbuf + ((size_t)(u.pm * BM + row) * 4 + u.pn);
            __hip_atomic_store(slot, ((unsigned long long)__float_as_uint(m2) << 32) | __float_as_uint(mt), __ATOMIC_RELAXED, __HIP_MEMORY_SCOPE_AGENT);
        }
        asm volatile("s_waitcnt vmcnt(0)" ::: "memory");
        if (lane == 0) __hip_atomic_fetch_add(cnt + 64 * u.pm, 1u, __ATOMIC_RELAXED, __HIP_MEMORY_SCOPE_AGENT);
        if (wid == 0) {
            bool dead = false; const unsigned long long t0 = __builtin_amdgcn_s_memrealtime(); const unsigned want = 8u * (unsigned)ntn;
            for (;;) {
#if defined(BROKEN_EXCHANGE_NO_WAIT)
                break;
#endif
                if ((unsigned)__builtin_amdgcn_readfirstlane(__hip_atomic_load(cnt + 64 * u.pm, __ATOMIC_RELAXED, __HIP_MEMORY_SCOPE_AGENT)) >= want) break;
                if (__builtin_amdgcn_s_memrealtime() - t0 > 2000000ull) {
                    if (lane == 0) { unsigned expect = 0u; __hip_atomic_compare_exchange_strong(tmo + 1, &expect, code | (unsigned)(u.pm & 0xff), __ATOMIC_RELAXED, __ATOMIC_RELAXED, __HIP_MEMORY_SCOPE_AGENT);
                                     __hip_atomic_store(tmo, 1u, __ATOMIC_RELAXED, __HIP_MEMORY_SCOPE_AGENT); }
                    dead = true; break; }
                __builtin_amdgcn_s_sleep(2);
            }
            __builtin_amdgcn_fence(__ATOMIC_ACQUIRE, "agent");
            if (lane == 0) flag[0] = dead ? 1u : 0u;
        }
        asm volatile("s_waitcnt vmcnt(0) lgkmcnt(0)" ::: "memory"); __builtin_amdgcn_s_barrier(); asm volatile("" ::: "memory");
        const bool bad = flag[0] != 0u;
        if (lane < 32) {
            const unsigned long long* slot = (const unsigned long long*)xbuf + (size_t)(u.pm * BM + row) * 4; float mt[4], m2[4]; float ms = 0.f;
#pragma unroll
            for (int t = 0; t < 4; ++t) { if (t < ntn) { const unsigned long long w = __hip_atomic_load(slot + t, __ATOMIC_RELAXED, __HIP_MEMORY_SCOPE_AGENT); mt[t] = __uint_as_float((unsigned)w); m2[t] = __uint_as_float((unsigned)(w >> 32)); } else { mt[t] = 0.f; m2[t] = 0.f; } ms += mt[t]; }
            const float mean = ms / (float)ntn; float q = 0.f;
#pragma unroll
            for (int t = 0; t < 4; ++t) if (t < ntn) { const float dm = mt[t] - mean; q += m2[t] + 256.0f * dm * dm; }
            S[row] = (f32x2v){mean, 1.0f / sqrtf(q / (256.0f * (float)ntn) + eps)};
        }
        asm volatile("s_waitcnt lgkmcnt(0)" ::: "memory"); __builtin_amdgcn_s_barrier(); asm volatile("" ::: "memory");
        return bad;
    }
};
template <bool ODD> struct EpiIn {
    static constexpr bool PERM = true, AFTER_DRAIN = false;
    bf16_t* P; const float* COS; const float* SIN;
    __device__ __forceinline__ void operator()(const f32x4 (&acc)[2][2][4][2], const Unit& u, int wr, int wc, int fr, int fq) const {
        const int row0 = u.pm * BM + wr * 64 + fr;
        int kind; float scale = 1.f;
        if (!ODD) { const int reg = u.pn >> 2; kind = reg < 2 ? 1 : (reg < 4 ? 2 : 0); if (reg == 3) scale = QK_SCALE; }
        else      { const int reg = u.pn >> 3; kind = reg < 2 ? 2 : 0; if (reg == 0) scale = QK_SCALE; }
        if (kind == 2) {
            const int hd = (wc >> 1) * 128, dlow = 32 * (wc & 1) + 8 * fq;
            bf16_t* pb = P + (size_t)u.pn * BM + hd + dlow;
#pragma unroll
            for (int ai = 0; ai < 2; ++ai)
#pragma unroll
                for (int m = 0; m < 4; ++m) { const int row = row0 + ai * HALF + m * 16, pos = row & (SEQ - 1);
                    const float* cp = COS + pos * 64 + dlow; const float* sp = SIN + pos * 64 + dlow;
                    const f32x4 c0 = *(const f32x4*)cp, c1 = *(const f32x4*)(cp + 4), s0 = *(const f32x4*)sp, s1 = *(const f32x4*)(sp + 4);
                    const f32x4 x10 = acc[ai][0][m][0], x11 = acc[ai][0][m][1], x20 = acc[ai][1][m][0], x21 = acc[ai][1][m][1];
                    const f32x4 a0 = (x10 * c0 - x20 * s0) * scale, a1 = (x11 * c1 - x21 * s1) * scale, b0 = (x20 * c0 + x10 * s0) * scale, b1 = (x21 * c1 + x11 * s1) * scale;
                    u32x4 w1, w2; w1.x = cvt_pk_bf16(a0[0], a0[1]); w1.y = cvt_pk_bf16(a0[2], a0[3]); w1.z = cvt_pk_bf16(a1[0], a1[1]); w1.w = cvt_pk_bf16(a1[2], a1[3]);
                    w2.x = cvt_pk_bf16(b0[0], b0[1]); w2.y = cvt_pk_bf16(b0[2], b0[3]); w2.z = cvt_pk_bf16(b1[0], b1[1]); w2.w = cvt_pk_bf16(b1[2], b1[3]);
                    bf16_t* rp = pb + (size_t)row * PP; *(u32x4*)rp = w1; *(u32x4*)(rp + 64) = w2;
                    asm volatile("" ::: "memory"); }
        } else {
            bf16_t* pb = P + (size_t)u.pn * BM + wc * 32 + 8 * fq;
#pragma unroll
            for (int ai = 0; ai < 2; ++ai)
#pragma unroll
                for (int m = 0; m < 4; ++m) { bf16_t* rp = pb + (size_t)(row0 + ai * HALF + m * 16) * PP;
#pragma unroll
                    for (int bj = 0; bj < 2; ++bj) { f32x4 v0 = acc[ai][bj][m][0], v1 = acc[ai][bj][m][1];
                        if (kind == 1) { v0 = (f32x4){silu_f(v0[0]), silu_f(v0[1]), silu_f(v0[2]), silu_f(v0[3])}; v1 = (f32x4){silu_f(v1[0]), silu_f(v1[1]), silu_f(v1[2]), silu_f(v1[3])}; }
                        u32x4 w; w.x = cvt_pk_bf16(v0[0], v0[1]); w.y = cvt_pk_bf16(v0[2], v0[3]); w.z = cvt_pk_bf16(v1[0], v1[1]); w.w = cvt_pk_bf16(v1[2], v1[3]);
                        *(u32x4*)(rp + bj * HALF) = w; } }
        }
    }
};
struct EpiGate {
    static constexpr bool PERM = true, AFTER_DRAIN = false;
    bf16_t* P;
    __device__ __forceinline__ void operator()(const f32x4 (&acc)[2][2][4][2], const Unit& u, int wr, int wc, int fr, int fq) const {
        const int row0 = u.pm * BM + wr * 64 + fr;
        bf16_t* pb = P + (size_t)u.pn * BM + wc * 32 + 8 * fq;
#pragma unroll
        for (int ai = 0; ai < 2; ++ai)
#pragma unroll
            for (int m = 0; m < 4; ++m) { bf16_t* rp = pb + (size_t)(row0 + ai * HALF + m * 16) * PP;
#pragma unroll
                for (int bj = 0; bj < 2; ++bj) { const f32x4 v0 = acc[ai][bj][m][0], v1 = acc[ai][bj][m][1]; const u32x4 a = *(const u32x4*)(rp + bj * HALF);
                    u32x4 w; w.x = cvt_pk_bf16(bf_lo(a.x) * silu_f(v0[0]), bf_hi(a.x) * silu_f(v0[1])); w.y = cvt_pk_bf16(bf_lo(a.y) * silu_f(v0[2]), bf_hi(a.y) * silu_f(v0[3]));
                    w.z = cvt_pk_bf16(bf_lo(a.z) * silu_f(v1[0]), bf_hi(a.z) * silu_f(v1[1])); w.w = cvt_pk_bf16(bf_lo(a.w) * silu_f(v1[2]), bf_hi(a.w) * silu_f(v1[3]));
                    *(u32x4*)(rp + bj * HALF) = w; }
                if (m & 1) asm volatile("" ::: "memory"); }
    }
};
struct EpiOut {
    static constexpr bool PERM = false, AFTER_DRAIN = false;
    const float* xres; float* Z; int ldz;
    __device__ __forceinline__ void operator()(const f32x4 (&acc)[2][2][4][2], const Unit& u, int wr, int wc, int fr, int fq) const {
        const int row0 = u.pm * BM + wr * 64 + fr, col0 = u.pn * BM + wc * 32 + 4 * fq;
#pragma unroll
        for (int ai = 0; ai < 2; ++ai)
#pragma unroll
            for (int m = 0; m < 4; ++m) { const int row = row0 + ai * HALF + m * 16; const float* xr = xres + (size_t)row * DM + col0; float* zr = Z + (size_t)row * ldz + col0;
#pragma unroll
                for (int bj = 0; bj < 2; ++bj)
#pragma unroll
                    for (int n = 0; n < 2; ++n) { const f32x4 x = *(const f32x4*)(xr + bj * HALF + n * 16); *(f32x4*)(zr + bj * HALF + n * 16) = acc[ai][bj][m][n] + x * DN_ALPHA; }
                if (m & 1) asm volatile("" ::: "memory"); }
    }
};
template <class Epi, class Sched, bool ALIGN_EPI = false, bool SP2 = false>
__device__ __forceinline__ void gemm_phase(PG8_LAS unsigned char* lds, const Gemm g, const Sched& S, const Epi& E) {
    int tid_ = threadIdx.x; asm volatile("" : "+v"(tid_));
    const int tid = tid_, wid = __builtin_amdgcn_readfirstlane(tid >> 6), lane = tid & 63, wr = wid >> 2, wc = wid & 3, fr = lane & 15, fq = lane >> 4;
    const int K = g.K, nt = K / BK;
    unsigned voffA[2], voffB[2];
#pragma unroll
    for (int i = 0; i < 2; ++i) { int R, C; stage_rc(tid * 16 + i * 8192, R, C); const int Rb = Epi::PERM ? ((R & ~31) + perm32(R & 31)) : R;
        voffA[i] = (unsigned)(R * g.lda + C) * 2u; voffB[i] = (unsigned)(Rb * K + C) * 2u; }
    const size_t kstep = (size_t)(BK * 2);
    const size_t hstepA = (size_t)HALF * g.lda * 2, hstepB = (size_t)HALF * K * 2;
    const size_t tstepA = 2 * hstepA, tstepB = 2 * hstepB;
    const unsigned ldsw = (unsigned)wid * 1024u;
    const int aoff = lds_byte(wr * 64 + fr, fq * 8), boff = lds_byte(wc * 32 + fr, fq * 8);
#define PG8_SA(b, h) (((b) * 2 + (h)) * HTB)
#define PG8_SB(b, h) ((4 + (b) * 2 + (h)) * HTB)
#define PG8_STAGE(bufoff, gbase, voff) do { _Pragma("unroll") for (int _i = 0; _i < 2; ++_i) \
        __builtin_amdgcn_global_load_lds((const unsigned*)((const char*)(gbase) + (voff)[_i]), (PG8_LAS unsigned*)(lds + (bufoff) + ldsw + _i * 8192), 16, 0, 0); } while (0)
#define PG8_LDA(dst, b, h) do { _Pragma("unroll") for (int m = 0; m < 4; ++m) _Pragma("unroll") for (int k = 0; k < 2; ++k) dst[m][k] = *(const PG8_LAS bf16x8*)(lds + PG8_SA(b, h) + aoff + m * 2048 + k * 1024); } while (0)
#define PG8_LDB(dst, b, h) do { _Pragma("unroll") for (int n = 0; n < 2; ++n) _Pragma("unroll") for (int k = 0; k < 2; ++k) dst[n][k] = *(const PG8_LAS bf16x8*)(lds + PG8_SB(b, h) + boff + n * 2048 + k * 1024); } while (0)
#define PG8_MMA(ai, bj, At, Bt) do { __builtin_amdgcn_s_setprio(1); _Pragma("unroll") for (int m = 0; m < 4; ++m) _Pragma("unroll") for (int n = 0; n < 2; ++n) _Pragma("unroll") for (int k = 0; k < 2; ++k) \
        acc[ai][bj][m][n] = __builtin_amdgcn_mfma_f32_16x16x32_bf16(Bt[n][k], At[m][k], acc[ai][bj][m][n], 0, 0, 0); __builtin_amdgcn_s_setprio(0); } while (0)
#define PG8_WAIT_V(n) asm volatile("s_waitcnt vmcnt(" #n ")" ::: "memory")
#define PG8_WAIT_L(n) asm volatile("s_waitcnt lgkmcnt(" #n ")" ::: "memory")
#define PG8_BAR __builtin_amdgcn_s_barrier()
#define PG8_SCHED __builtin_amdgcn_sched_barrier(0)
    Unit cur, nxt; int ui = 0;
    if (!S.next(0, cur)) return;
    f32x4 acc[2][2][4][2];
#pragma unroll
    for (int a = 0; a < 2; ++a)
#pragma unroll
        for (int b = 0; b < 2; ++b)
#pragma unroll
            for (int m = 0; m < 4; ++m)
#pragma unroll
                for (int n = 0; n < 2; ++n) acc[a][b][m][n] = (f32x4){0.f, 0.f, 0.f, 0.f};
    bf16x8 At[4][2], B0[2][2], B1[2][2];
    const char* cA = (const char*)g.A + (size_t)cur.pm * tstepA; const char* cB = (const char*)g.Bt + (size_t)cur.pn * tstepB;
    S.a_ready(cur);
    if constexpr (SP2) {
        PG8_STAGE(PG8_SB(0, 0), cB, voffB); PG8_STAGE(PG8_SB(0, 1), cB + hstepB, voffB); PG8_STAGE(PG8_SA(0, 0), cA, voffA); PG8_STAGE(PG8_SA(0, 1), cA + hstepA, voffA);
        if (wr == 1) PG8_BAR;
        PG8_WAIT_V(2); PG8_BAR;
        PG8_STAGE(PG8_SB(1, 0), cB + kstep, voffB); PG8_STAGE(PG8_SA(1, 0), cA + kstep, voffA); PG8_STAGE(PG8_SB(1, 1), cB + hstepB + kstep, voffB);
        PG8_WAIT_V(6); PG8_BAR;
    } else {
        PG8_STAGE(PG8_SB(0, 0), cB, voffB); PG8_STAGE(PG8_SA(0, 0), cA, voffA); PG8_STAGE(PG8_SB(0, 1), cB + hstepB, voffB); PG8_STAGE(PG8_SA(0, 1), cA + hstepA, voffA);
        if (wr == 1) PG8_BAR;
        PG8_WAIT_V(4); PG8_BAR;
        PG8_STAGE(PG8_SB(1, 0), cB + kstep, voffB); PG8_STAGE(PG8_SA(1, 0), cA + kstep, voffA); PG8_STAGE(PG8_SB(1, 1), cB + hstepB + kstep, voffB);
        PG8_WAIT_V(6); PG8_BAR;
    }
    for (;;) {
        const bool has_next = S.next(ui + 1, nxt);
        const char* nA = has_next ? (const char*)g.A + (size_t)nxt.pm * tstepA : cA; const char* nB = has_next ? (const char*)g.Bt + (size_t)nxt.pn * tstepB : cB;
        for (int t = 0; t < nt; t += 2) {
            const bool last = (t == nt - 2);
            const char* a1 = cA + (size_t)(t + 1) * kstep;
            const char* a2 = last ? nA : cA + (size_t)(t + 2) * kstep; const char* b2 = last ? nB : cB + (size_t)(t + 2) * kstep;
            const char* a3 = a2 + kstep; const char* b3 = b2 + kstep;
            if (last && has_next) S.a_ready(nxt);
            if constexpr (SP2) {
            PG8_LDB(B0, 0, 0); PG8_LDB(B1, 0, 1); PG8_SCHED; PG8_LDA(At, 0, 0); PG8_STAGE(PG8_SA(1, 1), a1 + hstepA, voffA);
            PG8_WAIT_V(8); PG8_WAIT_L(0); PG8_BAR; PG8_MMA(0, 0, At, B0); PG8_MMA(0, 1, At, B1); PG8_BAR; PG8_SCHED;
            PG8_LDA(At, 0, 1); PG8_STAGE(PG8_SB(0, 0), b2, voffB); PG8_STAGE(PG8_SB(0, 1), b2 + hstepB, voffB); PG8_STAGE(PG8_SA(0, 0), a2, voffA);
            PG8_WAIT_V(8); PG8_WAIT_L(0); PG8_BAR; PG8_MMA(1, 0, At, B0); PG8_MMA(1, 1, At, B1); PG8_BAR; PG8_SCHED;
            PG8_LDB(B0, 1, 0); PG8_LDB(B1, 1, 1); PG8_SCHED; PG8_LDA(At, 1, 0); PG8_STAGE(PG8_SA(0, 1), a2 + hstepA, voffA);
            PG8_WAIT_V(8); PG8_WAIT_L(0); PG8_BAR; PG8_MMA(0, 0, At, B0); PG8_MMA(0, 1, At, B1); PG8_BAR; PG8_SCHED;
            PG8_LDA(At, 1, 1); PG8_STAGE(PG8_SB(1, 0), b3, voffB); PG8_STAGE(PG8_SB(1, 1), b3 + hstepB, voffB); PG8_STAGE(PG8_SA(1, 0), a3, voffA);
            PG8_WAIT_V(8); PG8_WAIT_L(0); PG8_BAR; PG8_MMA(1, 0, At, B0); PG8_MMA(1, 1, At, B1); PG8_BAR; PG8_SCHED;
            } else {
            PG8_LDB(B0, 0, 0); PG8_SCHED; PG8_LDA(At, 0, 0); PG8_STAGE(PG8_SA(1, 1), a1 + hstepA, voffA);
            PG8_WAIT_L(8); PG8_BAR; PG8_WAIT_L(0); PG8_MMA(0, 0, At, B0); PG8_BAR; PG8_SCHED;
            PG8_LDB(B1, 0, 1); PG8_STAGE(PG8_SB(0, 0), b2, voffB);
            PG8_BAR; PG8_WAIT_L(0); PG8_MMA(0, 1, At, B1); PG8_BAR;
            PG8_LDA(At, 0, 1); PG8_STAGE(PG8_SA(0, 0), a2, voffA);
            PG8_BAR; PG8_WAIT_L(0); PG8_MMA(1, 0, At, B0); PG8_BAR; PG8_SCHED;
            PG8_STAGE(PG8_SB(0, 1), b2 + hstepB, voffB);
            PG8_WAIT_V(6); PG8_BAR; PG8_MMA(1, 1, At, B1); PG8_BAR;
            PG8_LDB(B0, 1, 0); PG8_SCHED; PG8_LDA(At, 1, 0); PG8_STAGE(PG8_SA(0, 1), a2 + hstepA, voffA);
            PG8_WAIT_L(8); PG8_BAR; PG8_WAIT_L(0); PG8_MMA(0, 0, At, B0); PG8_BAR; PG8_SCHED;
            PG8_LDB(B1, 1, 1); PG8_STAGE(PG8_SB(1, 0), b3, voffB);
            PG8_BAR; PG8_WAIT_L(0); PG8_MMA(0, 1, At, B1); PG8_BAR;
            PG8_LDA(At, 1, 1); PG8_STAGE(PG8_SA(1, 0), a3, voffA);
            PG8_BAR; PG8_WAIT_L(0); PG8_MMA(1, 0, At, B0); PG8_BAR; PG8_SCHED;
            PG8_STAGE(PG8_SB(1, 1), b3 + hstepB, voffB);
            PG8_WAIT_V(6); PG8_BAR; PG8_MMA(1, 1, At, B1); PG8_BAR;
            }
        }
        if constexpr (ALIGN_EPI) { if (wr == 0) PG8_BAR; }
        if constexpr (!Epi::AFTER_DRAIN) { E(acc, cur, wr, wc, fr, fq); S.done(cur); }
        if (!has_next) break;
#pragma unroll
        for (int a = 0; a < 2; ++a)
#pragma unroll
            for (int b = 0; b < 2; ++b)
#pragma unroll
                for (int m = 0; m < 4; ++m)
#pragma unroll
                    for (int n = 0; n < 2; ++n) acc[a][b][m][n] = (f32x4){0.f, 0.f, 0.f, 0.f};
        cur = nxt; cA = nA; cB = nB; ++ui;
        if constexpr (ALIGN_EPI) { if (wr == 1) PG8_BAR; }
    }
    PG8_WAIT_V(0);
    if constexpr (!ALIGN_EPI) { if (wr == 0) PG8_BAR; }
    PG8_BAR;
    if constexpr (Epi::AFTER_DRAIN) { E.fused(acc, cur, wr, wc, fr, fq, lds, wid, lane); S.done(cur); }
#undef PG8_SA
#undef PG8_SB
#undef PG8_STAGE
#undef PG8_LDA
#undef PG8_LDB
#undef PG8_MMA
#undef PG8_WAIT_V
#undef PG8_WAIT_L
#undef PG8_BAR
#undef PG8_SCHED
}
}

typedef GAS unsigned gu32;
#define XB_TMO      128
#define XB_XCNT(j)  (256  + 64 * (j))
#define XB_XSUB(j)  (1280 + 64 * (j))
#define XB_XGEN(j)  (2304 + 64 * (j))
#define XB_TOP      3328
#define XB_TOPGEN   3392
#define XCD_BAR_WORDS 3456
#define XB_SPIN_CAP (1u << 18)

__device__ __forceinline__ unsigned xb_ld(unsigned* p)              { return __hip_atomic_load(p, __ATOMIC_RELAXED, __HIP_MEMORY_SCOPE_AGENT); }
__device__ __forceinline__ unsigned xb_add(unsigned* p, unsigned v) { return __hip_atomic_fetch_add(p, v, __ATOMIC_RELAXED, __HIP_MEMORY_SCOPE_AGENT); }
__device__ __forceinline__ unsigned xb_xcc_id() { return (unsigned)__builtin_amdgcn_s_getreg((3 << 11) | 20) & 0xFu; }
#define XB_SPIN(cond, bar) do { unsigned _sp = 0; while (cond) { __builtin_amdgcn_s_sleep(1); \
    if ((++_sp & 255u) == 0u) { if (xb_ld(&(bar)[XB_TMO])) break; if (_sp > XB_SPIN_CAP) { atomicAdd(&(bar)[XB_TMO], 1u); break; } } } } while (0)

struct XcdBarrier {
    unsigned* bar; unsigned x;
    volatile LAS unsigned* st;
};

__device__ __forceinline__ XcdBarrier xcd_barrier_post(unsigned* bar, volatile LAS unsigned* st) {
    XcdBarrier b; b.bar = bar; b.x = xb_xcc_id(); b.st = st;
    if (threadIdx.x == 0) (void)xb_add(&bar[XB_XCNT(b.x)], 1u);
    return b;
}
__device__ __forceinline__ void xcd_barrier_complete(unsigned* bar, unsigned x, unsigned& nloc, unsigned& nx) {
    const unsigned G = gridDim.x * gridDim.y * gridDim.z;
    unsigned sum, cnt, mine, sp = 0u;
    for (;;) {
        sum = 0u; cnt = 0u; mine = 0u;
#pragma unroll
        for (unsigned j = 0; j < 16; ++j) { const unsigned c = xb_ld(&bar[XB_XCNT(j)]); sum += c; cnt += (c > 0u) ? 1u : 0u; mine = (j == x) ? c : mine; }
        if (sum == G) break;
        __builtin_amdgcn_s_sleep(1);
        if ((++sp & 255u) == 0u) { if (xb_ld(&bar[XB_TMO])) break; if (sp > XB_SPIN_CAP) { atomicAdd(&bar[XB_TMO], 1u); break; } }
    }
    nloc = mine > 0u ? mine : 1u; nx = cnt > 0u ? cnt : 1u;
}

__device__ __forceinline__ void xcd_barrier(const XcdBarrier& b) {
    asm volatile("s_waitcnt vmcnt(0)" ::: "memory");
    __syncthreads();
    if (threadIdx.x == 0) {
        unsigned* bar = b.bar; asm volatile("" : "+s"(bar));
        __builtin_amdgcn_s_waitcnt(0);
        unsigned nloc = b.st[0], nx = b.st[1];
        if (nloc == 0u) { xcd_barrier_complete(bar, b.x, nloc, nx); b.st[0] = nloc; b.st[1] = nx; }
        const unsigned old = xb_add(&bar[XB_XSUB(b.x)], 1u);
        const unsigned gen = old / nloc;
        if (old + 1u == (gen + 1u) * nloc) {
            __builtin_amdgcn_fence(__ATOMIC_RELEASE, "agent");
            asm volatile("s_waitcnt vmcnt(0)" ::: "memory");
            const unsigned og = xb_add(&bar[XB_TOP], 1u);
            const unsigned tg = og / nx;
            if (og + 1u == (tg + 1u) * nx) xb_add(&bar[XB_TOPGEN], 1u);
            else XB_SPIN(xb_ld(&bar[XB_TOPGEN]) == tg, bar);
            __builtin_amdgcn_fence(__ATOMIC_ACQUIRE, "agent");
            xb_add(&bar[XB_XGEN(b.x)], 1u);
            asm volatile("s_waitcnt vmcnt(0)" ::: "memory");
        } else {
            XB_SPIN(xb_ld(&bar[XB_XGEN(b.x)]) == gen, bar);
            __builtin_amdgcn_fence(__ATOMIC_ACQUIRE, "agent");
            asm volatile("s_waitcnt vmcnt(0)" ::: "memory");
        }
    }
    __syncthreads();
}


constexpr int NWAVES = 8;
struct Frame {
    LAS unsigned char* lds;
    int tid, lane, wave, vcu, G;
};
__device__ __forceinline__ float wave_sum(float v) {
#pragma unroll
    for (int o = 1; o < 64; o <<= 1) v += __shfl_xor(v, o);
    return v;
}
__device__ __forceinline__ void transpose_item(const float* W, int N, bf16* WT, int K, int dst_row0, int src_col0, int k0, LAS float* scr, int lane) {
#pragma unroll 8
    for (int i = 0; i < 32; ++i) { const int kk = 2 * i + (lane >> 5); scr[kk * 33 + (lane & 31)] = W[(size_t)(k0 + kk) * N + src_col0 + (lane & 31)]; }
    LDS_WAIT(); asm volatile("" ::: "memory");
    const int c = lane & 7;
#pragma unroll
    for (int j = 0; j < 4; ++j) { const int n = (lane >> 3) + 8 * j; const LAS float* s = scr + (8 * c) * 33 + n;
        u32x4 o; o.x = cvt_pk(s[0 * 33], s[1 * 33]); o.y = cvt_pk(s[2 * 33], s[3 * 33]); o.z = cvt_pk(s[4 * 33], s[5 * 33]); o.w = cvt_pk(s[6 * 33], s[7 * 33]);
        *(GAS u32x4*)(WT + (size_t)(dst_row0 + n) * K + k0 + 8 * c) = o; }
    LDS_WAIT(); asm volatile("" ::: "memory");
}
__device__ __forceinline__ int win_src_even(int n) {
    const int tile = n >> 8, p = n & 255, reg = tile >> 2, t = tile & 3;
    const int base = reg == 0 ? 3072 : reg == 1 ? 5120 : reg == 2 ? 0 : reg == 3 ? 1024 : reg == 4 ? 2048 : 4096;
    if (reg == 2 || reg == 3) { const int bj = p >> 7, j = p & 127; return base + (2 * t + (j >> 6)) * 128 + (j & 63) + 64 * bj; }
    return base + 256 * t + p;
}
__device__ __forceinline__ int win_src_odd(int n) {
    if (n >= 4096) return n;
    const int tile = n >> 8, p = n & 255, reg = tile >> 3, t = tile & 7, bj = p >> 7, j = p & 127;
    return reg * 2048 + (2 * t + (j >> 6)) * 128 + (j & 63) + 64 * bj;
}
template <bool ODD> __device__ __forceinline__ void conv_win(Frame& F, const float* W, bf16* WT) {
    LAS float* scr = (LAS float*)(F.lds + F.wave * 16384);
    int lane_o = F.lane; asm volatile("" : "+v"(lane_o));
    constexpr int N = ODD ? 8192 : 6144, NB = N / 32, NITEMS = 16 * NB;
    const int gw = F.vcu * NWAVES + F.wave, NGW = F.G * NWAVES;
    for (int it = gw; it < NITEMS; it += NGW) { const int kb = it / NB, nb = it % NB; const int src = ODD ? win_src_odd(32 * nb) : win_src_even(32 * nb);
        transpose_item(W, N, WT, 1024, 32 * nb, src, 64 * kb, scr, lane_o); }
}

__device__ __forceinline__ void sincos_d(float angf, float& s_out, float& c_out) {
    const double a = (double)angf; const double k = __builtin_rint(a * 0.63661977236758134308); const double r = (a - k * 1.57079632679489655800) - k * 6.12323399573676603587e-17;
    const double r2 = r * r;
    const double s = r * (1.0 + r2 * (-1.0 / 6 + r2 * (1.0 / 120 + r2 * (-1.0 / 5040 + r2 * (1.0 / 362880 + r2 * (-1.0 / 39916800 + r2 * (1.0 / 6227020800.0)))))));
    const double c = 1.0 + r2 * (-0.5 + r2 * (1.0 / 24 + r2 * (-1.0 / 720 + r2 * (1.0 / 40320 + r2 * (-1.0 / 3628800 + r2 * (1.0 / 479001600.0 + r2 * (-1.0 / 87178291200.0)))))));
    const int q = (int)((long long)k & 3);
    const double ss = (q == 0) ? s : (q == 1) ? c : (q == 2) ? -s : -c;
    const double cc = (q == 0) ? c : (q == 1) ? -s : (q == 2) ? -c : s;
    s_out = (float)ss; c_out = (float)cc;
}

struct Args { const float* in[23]; float* out; unsigned char* ws; int ph_lo, ph_hi; };

__device__ __forceinline__ void p0_prologue(Frame& F, const Args& A) {
    unsigned char* ws = A.ws;
    const int gw = F.vcu * NWAVES + F.wave, NGW = F.G * NWAVES, gt = gw * 64 + F.lane, NGT = NGW * 64;
    LAS float* scr = (LAS float*)(F.lds + F.wave * 16384);
    { const float* x = A.in[0]; bf16* x16 = (bf16*)(ws + WS_X16);
      for (size_t i = (size_t)gt; i < (size_t)MTOK * DM / 8; i += NGT) { const f32x4 a = *(const GAS f32x4*)(x + i * 8), b = *(const GAS f32x4*)(x + i * 8 + 4);
          u32x4 w; w.x = cvt_pk(a[0], a[1]); w.y = cvt_pk(a[2], a[3]); w.z = cvt_pk(b[0], b[1]); w.w = cvt_pk(b[2], b[3]); *(GAS u32x4*)(x16 + i * 8) = w; } }
    { float* COS = (float*)(ws + WS_ROPE); float* SIN = COS + SEQ * 64;
      for (int i = gt; i < SEQ * 64; i += NGT) { const int pos = i >> 6, f = i & 63;
          double w = 1.0; { double bpow = 0.86596432336006535; int e = f; while (e) { if (e & 1) w *= bpow; bpow *= bpow; e >>= 1; } }
          const float ang = (float)pos * (float)w; float s, c; sincos_d(ang, s, c); COS[i] = c; SIN[i] = s; } }
    if (gw < 2) { const int j = gw; const float* q1 = A.in[15] + j * 128, *k1 = A.in[16] + j * 128, *q2 = A.in[17] + j * 128, *k2 = A.in[18] + j * 128;
        float s1 = q1[F.lane] * k1[F.lane] + q1[F.lane + 64] * k1[F.lane + 64], s2 = q2[F.lane] * k2[F.lane] + q2[F.lane + 64] * k2[F.lane + 64];
        s1 = wave_sum(s1); s2 = wave_sum(s2);
        const float linit = (j == 0) ? 0.35550906759096927f : 0.55605820415654060f;
        if (F.lane == 0) { float* par = (float*)(ws + WS_PAR); par[j] = __expf(s1) - __expf(s2) + linit; } }
    conv_win<false>(F, A.in[1], (bf16*)(ws + WS_WIN));
    for (int it = gw; it < 4 * 1024; it += NGW) { const int l = it >> 10, r = it & 1023, kb = r >> 5, nb = r & 31;
        const float* W = (l & 1) ? A.in[20] + (size_t)(l >> 1) * 2048 * 1024 : A.in[11] + (size_t)(l >> 1) * 2048 * 1024;
        transpose_item(W, 1024, (bf16*)(ws + WS_WOUT) + (size_t)l * 2048 * 1024, 2048, 32 * nb, 32 * nb, 64 * kb, scr, F.lane); }
    for (int it = gw; it < 256; it += NGW) { const int mat = it >> 3, r = it & 7, kb = r >> 2, nb = r & 3;
        const int lj = mat >> 4, gate = (mat >> 3) & 1, blk = mat & 7; const float* W = A.in[gate ? 6 : 4] + ((size_t)lj * 8 + blk) * 128 * 128;
        transpose_item(W, 128, (bf16*)(ws + WS_WG) + (size_t)mat * 128 * 128, 128, 32 * nb, 32 * nb, 64 * kb, scr, F.lane); }
}

__device__ __forceinline__ void ln_phase(Frame& F, const float* Z, int ldz, const float* g, const float* bta, float* out, bf16* x16) {
    const int gw = F.vcu * NWAVES + F.wave, NGW = F.G * NWAVES;
    int lane_o = F.lane; asm volatile("" : "+v"(lane_o));
    f32x4 gv[4], bv[4];
#pragma unroll
    for (int j = 0; j < 4; ++j) { gv[j] = *(const GAS f32x4*)(g + 4 * lane_o + 256 * j); bv[j] = *(const GAS f32x4*)(bta + 4 * lane_o + 256 * j); }
    for (int m = gw; m < MTOK; m += NGW) {
        const GAS f32x4* zr = (const GAS f32x4*)(Z + (size_t)m * ldz) + lane_o;
        f32x4 v[4]; float s = 0.f;
#pragma unroll
        for (int j = 0; j < 4; ++j) { v[j] = zr[64 * j]; s += (v[j].x + v[j].y) + (v[j].z + v[j].w); }
        const float mean = wave_sum(s) * (1.f / DM); float s2 = 0.f;
#pragma unroll
        for (int j = 0; j < 4; ++j) { v[j] = v[j] - mean; s2 += (v[j].x * v[j].x + v[j].y * v[j].y) + (v[j].z * v[j].z + v[j].w * v[j].w); }
        const float rstd = 1.f / sqrtf(wave_sum(s2) * (1.f / DM) + NORM_EPS);
        GAS f32x4* o4 = (GAS f32x4*)(out + (size_t)m * DM) + lane_o; GAS u32x2* o2 = (GAS u32x2*)(x16 + (size_t)m * DM) + lane_o;
#pragma unroll
        for (int j = 0; j < 4; ++j) { const f32x4 y = v[j] * rstd * gv[j] + bv[j]; o4[64 * j] = y; u32x2 w; w.x = cvt_pk(y.x, y.y); w.y = cvt_pk(y.z, y.w); o2[64 * j] = w; }
    }
}

__device__ __forceinline__ void retention_unit(LAS unsigned char* lds, bf16* P, const float* gng, const float* gnb, int b, int h) {
    int tid_ = threadIdx.x; asm volatile("" : "+v"(tid_));
    const int tid = tid_, lane = tid & 63, wid = __builtin_amdgcn_readfirstlane(tid >> 6), r32 = lane & 31, hq = lane >> 5;
    const int ib = wid & 3, eh = wid >> 2;
    LAS unsigned char* QI = lds; LAS unsigned char* KI = lds + 32768; LAS unsigned char* VI = lds + 65536; LAS unsigned char* RI = lds + 98304;
    LAS float* ST = (LAS float*)(lds + LDS_X);
    LAS float* GN = (LAS float*)(lds + LDS_X + 2048);
    float lg; { const double x = 1.0 / (double)(1 << (5 + h)); double t = x, s = 0.0;
#pragma unroll
        for (int k = 1; k <= 10; ++k) { s += t / k; t *= x; } lg = (float)(-s * 1.4426950408889634); }
    const float g128 = __builtin_amdgcn_exp2f(128.f * lg);
    if (tid < 128) { GN[tid] = gng[h * 128 + tid]; GN[128 + tid] = gnb[h * 128 + tid]; }
    const unsigned rb0 = rr_base(lane, 0), rb1 = rr_base(lane, 1), tn0 = trn_base(lane, 0), tn1 = trn_base(lane, 1), tp0 = trp_base(lane, 0), tp1 = trp_base(lane, 1);
    f32x16 Racc[2]; Racc[0] = f32x16{}; Racc[1] = f32x16{};
    const int db = wid & 3, ebr = 2 * (wid >> 2);
    bf16* Pb = P + (size_t)b * SEQ * PP;
    for (int n = 0; n < 16; ++n) {
        bf16* Pc = Pb + (size_t)(128 * n) * PP;
#pragma unroll
        for (int k = 0; k < 4; ++k) { const int id = tid + 512 * k, row = id >> 4, ch = id & 15; const bf16* rp = Pc + (size_t)row * PP + 128 * h + 8 * ch;
            const u32x4 q = *(const GAS u32x4*)(rp + 2048), kk = *(const GAS u32x4*)(rp + 3072), v = *(const GAS u32x4*)(rp + 4096);
            const float f = __builtin_amdgcn_exp2f(-(float)(row + 1) * lg);
            u32x4 kd; kd.x = cvt_pk(bf_lo(kk.x) * f, bf_hi(kk.x) * f); kd.y = cvt_pk(bf_lo(kk.y) * f, bf_hi(kk.y) * f); kd.z = cvt_pk(bf_lo(kk.z) * f, bf_hi(kk.z) * f); kd.w = cvt_pk(bf_lo(kk.w) * f, bf_hi(kk.w) * f);
            const unsigned o = off_a(row, ch);
            *(LAS u32x4*)(QI + o) = q; *(LAS u32x4*)(KI + o) = kd; *(LAS u32x4*)(VI + o) = v;
            if (n == 0) *(LAS u32x4*)(RI + o) = (u32x4){0u, 0u, 0u, 0u}; }
        u32x2 sg[2][4];
        { const bf16* rp = Pc + (size_t)(32 * ib + r32) * PP + 128 * h + 64 * eh + 4 * hq;
#pragma unroll
          for (int e2 = 0; e2 < 2; ++e2)
#pragma unroll
              for (int g4 = 0; g4 < 4; ++g4) sg[e2][g4] = *(const GAS u32x2*)(rp + 32 * e2 + 8 * g4); }
        __syncthreads();
        bf16x8 qf[8];
#pragma unroll
        for (int s = 0; s < 8; ++s) qf[s] = *(const LAS bf16x8*)(QI + ib * 8192 + ((s & 1) ? rb1 : rb0) + 512 * (s >> 1));
        f32x16 acc[2]; acc[0] = f32x16{}; acc[1] = f32x16{};
#pragma unroll
        for (int ks = 0; ks < 8; ++ks)
#pragma unroll
            for (int e2 = 0; e2 < 2; ++e2) { const int c = 2 * eh + e2;
                const bf16x8 a = cat8(vtr(RI + tn0 + 4096 * ks + 512 * c), vtr(RI + tn1 + 4096 * ks + 512 * c));
                acc[e2] = __builtin_amdgcn_mfma_f32_32x32x16_bf16(a, qf[ks], acc[e2], 0, 0, 0); }
        for (int jb = 0; jb <= ib; ++jb) {
            f32x16 x = f32x16{};
#pragma unroll
            for (int ks = 0; ks < 8; ++ks) { const bf16x8 a = *(const LAS bf16x8*)(KI + jb * 8192 + ((ks & 1) ? rb1 : rb0) + 512 * (ks >> 1));
                x = __builtin_amdgcn_mfma_f32_32x32x16_bf16(a, qf[ks], x, 0, 0, 0); }
            if (jb == ib) {
#pragma unroll
                for (int r = 0; r < 16; ++r) if (crow(r, hq) > r32) x[r] = 0.f; }
            const bf16x8 xb0 = pack8f(x, 0), xb1 = pack8f(x, 8);
#pragma unroll
            for (int e2 = 0; e2 < 2; ++e2) { const int c = 2 * eh + e2;
                const bf16x8 a0 = cat8(vtr(VI + jb * 8192 + tp0 + 512 * c), vtr(VI + jb * 8192 + tp1 + 512 * c));
                const bf16x8 a1 = cat8(vtr(VI + jb * 8192 + tp0 + 4096 + 512 * c), vtr(VI + jb * 8192 + tp1 + 4096 + 512 * c));
                acc[e2] = __builtin_amdgcn_mfma_f32_32x32x16_bf16(a0, xb0, acc[e2], 0, 0, 0);
                acc[e2] = __builtin_amdgcn_mfma_f32_32x32x16_bf16(a1, xb1, acc[e2], 0, 0, 0); }
        }
        { const float sc = __builtin_amdgcn_exp2f((float)(32 * ib + r32 + 1) * lg); float s = 0.f, ss = 0.f;
#pragma unroll
          for (int e2 = 0; e2 < 2; ++e2)
#pragma unroll
              for (int r = 0; r < 16; ++r) { const float v = acc[e2][r] * sc; acc[e2][r] = v; s += v; ss += v * v; }
          s = swap32_sum(s); ss = swap32_sum(ss);
          if (hq == 0) { ST[(eh * 128 + 32 * ib + r32) * 2] = s; ST[(eh * 128 + 32 * ib + r32) * 2 + 1] = ss; } }
#pragma unroll
        for (int ks = 0; ks < 8; ++ks) { const bf16x8 bq = cat8(vtr(KI + tn0 + 4096 * ks + 512 * db), vtr(KI + tn1 + 4096 * ks + 512 * db));
#pragma unroll
            for (int e2 = 0; e2 < 2; ++e2) { const bf16x8 a = cat8(vtr(VI + tn0 + 4096 * ks + 512 * (ebr + e2)), vtr(VI + tn1 + 4096 * ks + 512 * (ebr + e2)));
                Racc[e2] = __builtin_amdgcn_mfma_f32_32x32x16_bf16(a, bq, Racc[e2], 0, 0, 0); } }
#pragma unroll
        for (int e2 = 0; e2 < 2; ++e2)
#pragma unroll
            for (int r = 0; r < 16; ++r) Racc[e2][r] *= g128;
        __syncthreads();
#pragma unroll
        for (int e2 = 0; e2 < 2; ++e2)
#pragma unroll
            for (int g4 = 0; g4 < 4; ++g4) { u32x2 w; w.x = cvt_pk(Racc[e2][4 * g4], Racc[e2][4 * g4 + 1]); w.y = cvt_pk(Racc[e2][4 * g4 + 2], Racc[e2][4 * g4 + 3]);
                *(LAS u32x2*)(RI + off_a(32 * db + r32, 4 * (ebr + e2) + g4) + 8 * hq) = w; }
        { const int i = 32 * ib + r32; const float s = ST[i * 2] + ST[(128 + i) * 2], ss = ST[i * 2 + 1] + ST[(128 + i) * 2 + 1];
          const float mean = s * (1.f / 128.f), var = fmaxf(ss * (1.f / 128.f) - mean * mean, 0.f), rstd = 1.f / sqrtf(var + NORM_EPS);
          bf16* op = Pc + (size_t)i * PP + 128 * h + 64 * eh + 4 * hq;
#pragma unroll
          for (int e2 = 0; e2 < 2; ++e2)
#pragma unroll
              for (int g4 = 0; g4 < 4; ++g4) { const int e0 = 64 * eh + 32 * e2 + 8 * g4 + 4 * hq; const f32x4 gg = *(const LAS f32x4*)(GN + e0), gb = *(const LAS f32x4*)(GN + 128 + e0);
                  const u32x2 gt = sg[e2][g4];
                  const float o0 = ((acc[e2][4 * g4 + 0] - mean) * rstd * gg[0] + gb[0]) * bf_lo(gt.x), o1 = ((acc[e2][4 * g4 + 1] - mean) * rstd * gg[1] + gb[1]) * bf_hi(gt.x);
                  const float o2 = ((acc[e2][4 * g4 + 2] - mean) * rstd * gg[2] + gb[2]) * bf_lo(gt.y), o3 = ((acc[e2][4 * g4 + 3] - mean) * rstd * gg[3] + gb[3]) * bf_hi(gt.y);
                  u32x2 w; w.x = cvt_pk(o0, o1); w.y = cvt_pk(o2, o3); *(GAS u32x2*)(op + 32 * e2 + 8 * g4) = w; } }
    }
    __syncthreads();
}

__device__ __forceinline__ float softplus_f(float x) {
    if (x > 20.f) return x;
    const float y = __builtin_amdgcn_exp2f(x * LOG2E);
    if (y < 0.25f) { return y * (1.f + y * (-0.5f + y * (1.f / 3 + y * (-0.25f + y * (0.2f + y * (-1.f / 6 + y * (1.f / 7 + y * (-0.125f + y * (1.f / 9 + y * (-0.1f)))))))))); }
    return __builtin_amdgcn_logf(1.f + y) * 0.6931471805599453f;
}
__device__ __forceinline__ void lru_unit(LAS unsigned char* lds, bf16* P, const bf16* WG, const float* conv_w, const float* conv_b, const float* ba, const float* bx, const float* lam, int b, int g) {
    int tid_ = threadIdx.x; asm volatile("" : "+v"(tid_));
    const int tid = tid_, lane = tid & 63, wid = __builtin_amdgcn_readfirstlane(tid >> 6), r32 = lane & 31, hq = lane >> 5;
    const int tb = wid & 1, jb = wid >> 1;
    LAS unsigned char* XC = lds;
    LAS float* XCF = (LAS float*)(lds + 16384);
    LAS float* AF = (LAS float*)(lds + 49152);
    LAS float* UF = (LAS float*)(lds + 81920);
    LAS float* COMP = (LAS float*)(lds + 114688);
    LAS float* HC = (LAS float*)(lds + 118784);
    LAS float* CW = (LAS float*)(lds + 119808);
    for (int i = tid; i < 640; i += 512) { const int w = i >> 7, c = i & 127; CW[i] = (w < 4) ? conv_w[w * 1024 + 128 * g + c] : conv_b[128 * g + c]; }
    if (tid < 256) HC[tid] = 0.f;
    const unsigned rb0 = rr_base(lane, 0), rb1 = rr_base(lane, 1);
    bf16x8 waf[8], wxf[8];
    { const bf16* wa = WG + (size_t)g * 16384 + (size_t)(32 * jb + r32) * 128 + 8 * hq; const bf16* wx = wa + 8 * 16384;
#pragma unroll
      for (int ks = 0; ks < 8; ++ks) { waf[ks] = *(const GAS bf16x8*)(wa + 16 * ks); wxf[ks] = *(const GAS bf16x8*)(wx + 16 * ks); } }
    const int cj = 128 * g + 32 * jb + r32;
    const float bac = ba[cj], bxc = bx[cj], spc = softplus_f(-lam[cj]);
    bf16* Pb = P + (size_t)b * SEQ * PP;
    const int oct = tid & 15, tp = tid >> 4;
    const int sc_c = tid & 127, sc_seg = tid >> 7;
    __syncthreads();
    for (int n = 0; n < 32; ++n) {
        { const int t0 = 64 * n + 2 * tp; u32x4 xr[5];
#pragma unroll
          for (int k = 0; k < 5; ++k) { const int t = t0 - 3 + k; xr[k] = (t >= 0) ? *(const GAS u32x4*)(Pb + (size_t)t * PP + 5120 + 128 * g + 8 * oct) : (u32x4){0u, 0u, 0u, 0u}; }
          f32x4 o[2][2];
          { const f32x4 b0 = *(const LAS f32x4*)(CW + 512 + 8 * oct), b1 = *(const LAS f32x4*)(CW + 512 + 8 * oct + 4); o[0][0] = b0; o[0][1] = b1; o[1][0] = b0; o[1][1] = b1; }
#pragma unroll
          for (int w = 0; w < 4; ++w) { const f32x4 w0 = *(const LAS f32x4*)(CW + 128 * w + 8 * oct), w1 = *(const LAS f32x4*)(CW + 128 * w + 8 * oct + 4);
#pragma unroll
              for (int rr = 0; rr < 2; ++rr) { const u32x4 x = xr[rr + w];
                  o[rr][0] += w0 * (f32x4){bf_lo(x.x), bf_hi(x.x), bf_lo(x.y), bf_hi(x.y)}; o[rr][1] += w1 * (f32x4){bf_lo(x.z), bf_hi(x.z), bf_lo(x.w), bf_hi(x.w)}; } }
#pragma unroll
          for (int rr = 0; rr < 2; ++rr) { const int t = 2 * tp + rr; *(LAS f32x4*)(XCF + t * 128 + 8 * oct) = o[rr][0]; *(LAS f32x4*)(XCF + t * 128 + 8 * oct + 4) = o[rr][1];
              u32x4 w; w.x = cvt_pk(o[rr][0][0], o[rr][0][1]); w.y = cvt_pk(o[rr][0][2], o[rr][0][3]); w.z = cvt_pk(o[rr][1][0], o[rr][1][1]); w.w = cvt_pk(o[rr][1][2], o[rr][1][3]);
              *(LAS u32x4*)(XC + off_a(t, oct)) = w; } }
        unsigned short sgl[16];
        { const bf16* gp = Pb + (size_t)(64 * n + 16 * sc_seg) * PP + 1024 + 128 * g + sc_c;
#pragma unroll
          for (int t = 0; t < 16; ++t) sgl[t] = gp[(size_t)t * PP]; }
        __syncthreads();
        { f32x16 ga = f32x16{}, gx = f32x16{};
#pragma unroll
          for (int ks = 0; ks < 8; ++ks) { const bf16x8 a = *(const LAS bf16x8*)(XC + tb * 8192 + ((ks & 1) ? rb1 : rb0) + 512 * (ks >> 1));
              ga = __builtin_amdgcn_mfma_f32_32x32x16_bf16(a, waf[ks], ga, 0, 0, 0); gx = __builtin_amdgcn_mfma_f32_32x32x16_bf16(a, wxf[ks], gx, 0, 0, 0); }
#pragma unroll
          for (int r = 0; r < 16; ++r) { const int t = 32 * tb + crow(r, hq), c = 32 * jb + r32;
              const float rg = sigmoid_f(ga[r] + bac), ig = sigmoid_f(gx[r] + bxc);
              const float la = -8.f * rg * spc, a = __builtin_amdgcn_exp2f(la * LOG2E), z = 2.f * la;
              const float om = (z > -0.3f) ? -z * (1.f + z * (0.5f + z * (1.f / 6 + z * (1.f / 24 + z * (1.f / 120 + z * (1.f / 720 + z * (1.f / 5040))))))) : 1.f - a * a;
              AF[t * 128 + c] = a; UF[t * 128 + c] = XCF[t * 128 + c] * ig * sqrtf(om); } }
        __syncthreads();
        { float A = 1.f, B = 0.f;
#pragma unroll
          for (int t = 0; t < 16; ++t) { const float a = AF[(16 * sc_seg + t) * 128 + sc_c], u = UF[(16 * sc_seg + t) * 128 + sc_c]; B = a * B + u; A = a * A; }
          COMP[(sc_seg * 128 + sc_c) * 2] = A; COMP[(sc_seg * 128 + sc_c) * 2 + 1] = B; }
        __syncthreads();
        { float hv = HC[(n & 1) * 128 + sc_c];
          for (int s = 0; s < sc_seg; ++s) hv = COMP[(s * 128 + sc_c) * 2] * hv + COMP[(s * 128 + sc_c) * 2 + 1];
          bf16* op = Pb + (size_t)(64 * n + 16 * sc_seg) * PP + 1024 + 128 * g + sc_c;
#pragma unroll
          for (int t = 0; t < 16; ++t) { const float a = AF[(16 * sc_seg + t) * 128 + sc_c], u = UF[(16 * sc_seg + t) * 128 + sc_c]; hv = a * hv + u;
              const float o = hv * __uint_as_float((unsigned)sgl[t] << 16); op[(size_t)t * PP] = (bf16)(cvt_pk(o, 0.f) & 0xffffu); }
          if (sc_seg == 3) HC[((n + 1) & 1) * 128 + sc_c] = hv; }
    }
    __syncthreads();
}

constexpr int AT_STAGE = 65536;
__device__ __forceinline__ void attn_dma(LAS unsigned char* lds, const bf16* Pb, int h, int tile, int stage, int wid, int lane) {
    const int img = wid >> 1, jb0 = 8 * (wid & 1);
    const int colbase = (img < 2) ? 2048 + (2 * h + img) * 128 : 4096 + 256 * h + 128 * (img - 2);
    const bf16* src0 = Pb + (size_t)(64 * tile) * PP + colbase;
#pragma unroll
    for (int k = 0; k < 8; ++k) { const int j = jb0 + k; const int rowp = 8 * (j >> 1) + ((lane >> 2) & 7), chg = 2 * (j & 1) + (lane >> 5), ch = 4 * chg + ((lane & 3) ^ ((rowp >> 2) & 3));
        __builtin_amdgcn_global_load_lds((const GAS unsigned*)(src0 + (size_t)rowp * PP + 8 * ch), (LAS unsigned*)(lds + stage * AT_STAGE + img * 16384 + j * 1024), 16, 0, 0); }
}
__device__ __forceinline__ void attn_qblock(LAS unsigned char* lds, bf16* P, const float* subg, float lamv, float omli, int b, int h, int qb) {
    int tid_ = threadIdx.x; asm volatile("" : "+v"(tid_));
    const int tid = tid_, lane = tid & 63, wid = __builtin_amdgcn_readfirstlane(tid >> 6), r32 = lane & 31, hq = lane >> 5;
    const int map = wid >> 2, wq = wid & 3;
    bf16* Pb = P + (size_t)b * SEQ * PP;
    const int rowpos = 128 * qb + 32 * wq + r32;
    bf16x8 qf[8];
    { const bf16* qp = Pb + (size_t)rowpos * PP + (2 * h + map) * 128 + 8 * hq;
#pragma unroll
      for (int s = 0; s < 8; ++s) qf[s] = *(const GAS bf16x8*)(qp + 16 * s); }
    const int NT = 2 * qb + 2;
    const unsigned rb0 = rr_base(lane, 0) + map * 16384, rb1 = rr_base(lane, 1) + map * 16384, tp0 = trp_base(lane, 0) + 32768, tp1 = trp_base(lane, 1) + 32768;
    f32x16 o[8];
#pragma unroll
    for (int c = 0; c < 8; ++c) o[c] = f32x16{};
    float m_run = -1e30f, l_run = 0.f;
    attn_dma(lds, Pb, h, 0, 0, wid, lane);
    __syncthreads();
    for (int t = 0; t < NT; ++t) {
        const int st = t & 1;
        if (t + 1 < NT) attn_dma(lds, Pb, h, t + 1, st ^ 1, wid, lane);
        const LAS unsigned char* SB = lds + st * AT_STAGE;
        f32x16 p0 = f32x16{}, p1 = f32x16{};
#pragma unroll
        for (int ks = 0; ks < 8; ++ks) { const unsigned ko = ((ks & 1) ? rb1 : rb0) + 512 * (ks >> 1);
            const bf16x8 a0 = *(const LAS bf16x8*)(SB + ko), a1 = *(const LAS bf16x8*)(SB + ko + 8192);
            p0 = __builtin_amdgcn_mfma_f32_32x32x16_bf16(a0, qf[ks], p0, 0, 0, 0); p1 = __builtin_amdgcn_mfma_f32_32x32x16_bf16(a1, qf[ks], p1, 0, 0, 0); }
        if (t >= NT - 2) { const int kb = 64 * t; const float NEG = -__builtin_inff();
#pragma unroll
            for (int r = 0; r < 16; ++r) { const int key = kb + crow(r, hq); if (key > rowpos) p0[r] = NEG; if (key + 32 > rowpos) p1[r] = NEG; } }
        float pmax = p0[0];
#pragma unroll
        for (int r = 1; r < 16; ++r) pmax = fmaxf(pmax, p0[r]);
#pragma unroll
        for (int r = 0; r < 16; ++r) pmax = fmaxf(pmax, p1[r]);
        pmax = swap32_max(pmax);
        if (!__all((pmax - m_run) * LOG2E <= 8.f)) {
            const float mn = fmaxf(m_run, pmax), alpha = __builtin_amdgcn_exp2f((m_run - mn) * LOG2E); m_run = mn; l_run *= alpha;
#pragma unroll
            for (int c = 0; c < 8; ++c)
#pragma unroll
                for (int r = 0; r < 16; ++r) o[c][r] *= alpha; }
        { const float ml = -m_run * LOG2E; float ps = 0.f;
#pragma unroll
          for (int r = 0; r < 16; ++r) { p0[r] = __builtin_amdgcn_exp2f(fmaf(p0[r], LOG2E, ml)); ps += p0[r]; }
#pragma unroll
          for (int r = 0; r < 16; ++r) { p1[r] = __builtin_amdgcn_exp2f(fmaf(p1[r], LOG2E, ml)); ps += p1[r]; }
          l_run += ps; }
        bf16x8 pb[4]; pb[0] = pack8f(p0, 0); pb[1] = pack8f(p0, 8); pb[2] = pack8f(p1, 0); pb[3] = pack8f(p1, 8);
#pragma unroll
        for (int c = 0; c < 8; ++c)
#pragma unroll
            for (int ks = 0; ks < 4; ++ks) { const unsigned vo = (c >> 2) * 16384 + 512 * (c & 3) + 4096 * ks;
                const bf16x8 a = cat8(vtr(SB + tp0 + vo), vtr(SB + tp1 + vo));
                o[c] = __builtin_amdgcn_mfma_f32_32x32x16_bf16(a, pb[ks], o[c], 0, 0, 0); }
        __syncthreads();
    }
    { const float inv = 1.f / swap32_sum(l_run); const float f = (map == 1) ? inv * lamv : inv;
      LAS float* XB = (LAS float*)lds + (size_t)wq * 8 * 16 * 64 + lane;
      if (map == 1) {
#pragma unroll
          for (int c = 0; c < 8; ++c)
#pragma unroll
              for (int r = 0; r < 16; ++r) XB[(c * 16 + r) * 64] = o[c][r] * f; }
      __syncthreads();
      if (map == 0) { float ss = 0.f;
#pragma unroll
          for (int c = 0; c < 8; ++c)
#pragma unroll
              for (int r = 0; r < 16; ++r) { const float d = o[c][r] * f - XB[(c * 16 + r) * 64]; o[c][r] = d; ss += d * d; }
          ss = swap32_sum(ss); const float rs = omli / sqrtf(ss * (1.f / 256.f) + NORM_EPS);
          bf16* op = Pb + (size_t)rowpos * PP + 256 * h + 4 * hq;
#pragma unroll
          for (int c = 0; c < 8; ++c)
#pragma unroll
              for (int g4 = 0; g4 < 4; ++g4) { const f32x4 gg = *(const GAS f32x4*)(subg + 32 * c + 8 * g4 + 4 * hq);
                  u32x2 w; w.x = cvt_pk(o[c][4 * g4] * rs * gg[0], o[c][4 * g4 + 1] * rs * gg[1]); w.y = cvt_pk(o[c][4 * g4 + 2] * rs * gg[2], o[c][4 * g4 + 3] * rs * gg[3]);
                  *(GAS u32x2*)(op + 32 * c + 8 * g4) = w; } }
      __syncthreads(); }
}


#define IN(k) (lo <= (k) && (k) < hi)
#define SEAM(k) do { if (IN(k) && IN((k) + 1)) xcd_barrier(bar); } while (0)
template <int j> __device__ __forceinline__ void layer_pair(Frame& F, const Args& args, const int lo, const int hi, const XcdBarrier& bar) {
    unsigned char* ws; constexpr int LDZ = PP / 2;
        const int pb = 1 + 9 * j;
        { unsigned char* wsj = args.ws; asm volatile("" : "+s"(wsj)); ws = wsj; }
        int Gj = gridDim.x, bxj = blockIdx.x, vcuj = F.vcu; asm volatile("" : "+s"(Gj), "+s"(bxj), "+s"(vcuj)); F.G = Gj; F.vcu = vcuj;
        bf16* P = (bf16*)(ws + WS_P); bf16* X16 = (bf16*)(ws + WS_X16); bf16* WIN = (bf16*)(ws + WS_WIN);
        const float* COS = (const float*)(ws + WS_ROPE); const float* SIN = COS + SEQ * 64;
        float* Z = (float*)(ws + WS_P) + 1024;
        if (IN(pb + 0)) {
            pg8::Gemm g{X16, WIN, MTOK, 6144, 1024, 1024}; pg8::StaticOrder S; S.init(MTOK, 6144, F.G, bxj);
            pg8::EpiIn<false> E{P, COS, SIN};
#ifndef NO_E1
            pg8::gemm_phase<pg8::EpiIn<false>, pg8::StaticOrder, true, true>(F.lds, g, S, E);
#endif
        } SEAM(pb + 0);
        if (IN(pb + 1)) {
            for (int u = F.vcu; u < 256; u += F.G) {
#ifndef NO_RET
                if (u < 128) retention_unit(F.lds, P, args.in[9] + j * 1024, args.in[10] + j * 1024, u >> 3, u & 7);
#endif
#ifndef NO_LRU
                if (u >= 128) { const int v = u - 128; lru_unit(F.lds, P, (const bf16*)(ws + WS_WG) + (size_t)j * 2 * 8 * 16384, args.in[2] + j * 4096, args.in[3] + j * 1024,
                                                        args.in[5] + j * 1024, args.in[7] + j * 1024, args.in[8] + j * 1024, v >> 3, v & 7); }
#endif
            }
        } SEAM(pb + 1);
        if (IN(pb + 2)) {
            pg8::Gemm g{P, (const bf16*)(ws + WS_WOUT) + (size_t)(2 * j) * 2048 * 1024, MTOK, 1024, 2048, PP}; pg8::StaticOrder S; S.init(MTOK, 1024, F.G, bxj);
            pg8::EpiOut E{j == 0 ? args.in[0] : args.out, Z, LDZ};
#ifndef NO_E3
            pg8::gemm_phase<pg8::EpiOut, pg8::StaticOrder, true, true>(F.lds, g, S, E);
#endif
        } SEAM(pb + 2);
        if (IN(pb + 3)) {
#ifndef NO_LN
            ln_phase(F, Z, LDZ, args.in[12] + j * 1024, args.in[13] + j * 1024, args.out, X16);
            conv_win<true>(F, args.in[14] + (size_t)j * 1024 * 8192, WIN);
#endif
        } SEAM(pb + 3);
        if (IN(pb + 4)) {
            pg8::Gemm g{X16, WIN, MTOK, 6144, 1024, 1024}; pg8::StaticOrder S; S.init(MTOK, 6144, F.G, bxj);
            pg8::EpiIn<true> E{P, COS, SIN};
#ifndef NO_O1
            pg8::gemm_phase<pg8::EpiIn<true>, pg8::StaticOrder, true, true>(F.lds, g, S, E);
#endif
        } SEAM(pb + 4);
        if (IN(pb + 5)) {
            const float lamv = ((const float*)(ws + WS_PAR))[j]; const float omli = 1.f - ((j == 0) ? 0.35550906759096927f : 0.55605820415654060f);
            for (int it = F.vcu; it < 1024; it += F.G) { const int bh = it >> 3, x = it & 7;
#ifndef NO_ATT
                attn_qblock(F.lds, P, args.in[19] + j * 256, lamv, omli, bh >> 3, bh & 7, 15 - x);
                attn_qblock(F.lds, P, args.in[19] + j * 256, lamv, omli, bh >> 3, bh & 7, x);
#endif
            }
        } SEAM(pb + 5);
        if (IN(pb + 6)) {
            pg8::Gemm g{X16, WIN + (size_t)6144 * 1024, MTOK, 2048, 1024, 1024}; pg8::StaticOrder S; S.init(MTOK, 2048, F.G, bxj);
            pg8::EpiGate E{P};
#ifndef NO_O3
            pg8::gemm_phase<pg8::EpiGate, pg8::StaticOrder, true, true>(F.lds, g, S, E);
#endif
        } SEAM(pb + 6);
        if (IN(pb + 7)) {
            pg8::Gemm g{P, (const bf16*)(ws + WS_WOUT) + (size_t)(2 * j + 1) * 2048 * 1024, MTOK, 1024, 2048, PP}; pg8::StaticOrder S; S.init(MTOK, 1024, F.G, bxj);
            pg8::EpiOut E{args.out, Z, LDZ};
#ifndef NO_O4
            pg8::gemm_phase<pg8::EpiOut, pg8::StaticOrder, true, true>(F.lds, g, S, E);
#endif
        } SEAM(pb + 7);
        if (IN(pb + 8)) {
#ifndef NO_LN
            ln_phase(F, Z, LDZ, args.in[21] + j * 1024, args.in[22] + j * 1024, args.out, X16);
            if (j == 0) conv_win<false>(F, args.in[1] + (size_t)1024 * 6144, WIN);
#endif
        } SEAM(pb + 8);
}
#undef IN
#undef SEAM
constexpr int N_PHASES = 19;
__global__ void __launch_bounds__(NWAVES * 64, 2) fwd_kernel(Args args) {
    extern __shared__ __attribute__((aligned(16))) unsigned char lds_raw[];
    Frame F;
    F.lds = (LAS unsigned char*)lds_raw;
    F.tid = threadIdx.x; F.lane = F.tid & 63; F.wave = __builtin_amdgcn_readfirstlane(F.tid >> 6);
    F.G = gridDim.x; { const int bx = blockIdx.x; F.vcu = (F.G % 8 == 0) ? (bx % 8) * (F.G / 8) + bx / 8 : bx; }
    unsigned char* ws = args.ws;
    gu32* ctl = (gu32*)(ws + WS_CTL);
    volatile LAS unsigned* MISC = (volatile LAS unsigned*)(F.lds + MISC_OFF);
    if (F.tid < 64) MISC[F.tid] = 0u;
    __syncthreads();
    const int lo = args.ph_lo, hi = args.ph_hi;
    XcdBarrier bar; bar.bar = (unsigned*)(ctl + CW_BAR); bar.x = 0; bar.st = nullptr;
    if (hi - lo > 1) bar = xcd_barrier_post((unsigned*)(ctl + CW_BAR), MISC + 8);
#define IN(k) (lo <= (k) && (k) < hi)
#define SEAM(k) do { if (IN(k) && IN((k) + 1)) xcd_barrier(bar); } while (0)
    constexpr int LDZ = PP / 2;

#ifndef NO_P0
    if (IN(0)) { p0_prologue(F, args); } SEAM(0);
#else
    SEAM(0);
#endif

    layer_pair<0>(F, args, lo, hi, bar);
    layer_pair<1>(F, args, lo, hi, bar);
#undef IN
#undef SEAM
}

extern "C" void kernel_launch(void* const* d_in, const int* in_sizes, int n_in, void* d_out, int out_size, void* d_ws, size_t ws_size, hipStream_t stream) {
    static int grid = 0;
    if (grid == 0) {
        if (n_in != 23 || in_sizes[0] != MTOK * DM || out_size != MTOK * DM || ws_size < WS_END) {
            fprintf(stderr, "kernel_launch: unexpected shapes (n_in %d, in0 %d, out %d, ws %zu < %zu); nothing launched\n", n_in, n_in > 0 ? in_sizes[0] : -1, out_size, ws_size, (size_t)WS_END); grid = -1; return; }
        int dev = 0, cus = 0, per_cu = 0;
        if (hipGetDevice(&dev) != hipSuccess || hipDeviceGetAttribute(&cus, hipDeviceAttributeMultiprocessorCount, dev) != hipSuccess) { grid = -1; return; }
        if (hipFuncSetAttribute((const void*)fwd_kernel, hipFuncAttributeMaxDynamicSharedMemorySize, LDS_BYTES) != hipSuccess) { fprintf(stderr, "kernel_launch: hipFuncSetAttribute failed\n"); grid = -1; return; }
        if (hipOccupancyMaxActiveBlocksPerMultiprocessor(&per_cu, (const void*)fwd_kernel, NWAVES * 64, LDS_BYTES) != hipSuccess || per_cu < 1)
            fprintf(stderr, "kernel_launch: note: occupancy query reports %d workgroups per CU\n", per_cu);
        (void)hipGetLastError();
        grid = cus;
    }
    if (grid < 0) return;
    (void)hipMemsetAsync((char*)d_ws + WS_CTL, 0, CTL_ZERO_BYTES, stream);
    Args a{};
    for (int i = 0; i < 23; ++i) a.in[i] = (const float*)d_in[i];
    a.out = (float*)d_out; a.ws = (unsigned char*)d_ws;
#if MK_SPLIT
    for (int p = 0; p < N_PHASES; ++p) { a.ph_lo = p; a.ph_hi = p + 1; hipLaunchKernelGGL(fwd_kernel, dim3(grid), dim3(NWAVES * 64), LDS_BYTES, stream, a); }
#else
    a.ph_lo = 0; a.ph_hi = N_PHASES;
    hipLaunchKernelGGL(fwd_kernel, dim3(grid), dim3(NWAVES * 64), LDS_BYTES, stream, a);
#endif
    const hipError_t le = hipPeekAtLastError();
    if (le != hipSuccess) fprintf(stderr, "kernel_launch: launch failed: %s\n", hipGetErrorName(le));
}
```

```cpp
#include <hip/hip_runtime.h>
#include <cstdio>
#include <cstdint>

#ifndef MK_SPLIT
#define MK_SPLIT 0
#endif

#ifndef PROBE_MASK
#define PROBE_MASK 0
#endif
#define GAS __attribute__((address_space(1)))
#define LAS __attribute__((address_space(3)))
typedef unsigned short bf16;
typedef short bf16x8 __attribute__((ext_vector_type(8)));
typedef short s16x4 __attribute__((ext_vector_type(4)));
typedef float f32x4 __attribute__((ext_vector_type(4)));
typedef float f32x16 __attribute__((ext_vector_type(16)));
typedef unsigned u32x4 __attribute__((ext_vector_type(4)));
typedef unsigned u32x2 __attribute__((ext_vector_type(2)));

constexpr int BATCH = 16, SEQ = 2048, DM = 1024, MTOK = BATCH * SEQ;
constexpr int PP = 6144;
constexpr float DN_ALPHA = 1.6817928305074290f;
constexpr float NORM_EPS = 1e-5f;
constexpr float QK_SCALE = 0.08838834764831845f;
constexpr float LOG2E = 1.4426950408889634f;

constexpr size_t MiB = 1u << 20;
constexpr size_t WS_CTL = 0, CTL_ZERO_BYTES = 1 * MiB;
constexpr size_t WS_ROPE = 1 * MiB;
constexpr size_t WS_PAR = 2 * MiB;
constexpr size_t WS_WG = 3 * MiB;
constexpr size_t WS_WOUT = 4 * MiB;
constexpr size_t WS_WIN = 20 * MiB;
constexpr size_t WS_X16 = 36 * MiB;
constexpr size_t WS_P = 100 * MiB;
constexpr size_t WS_END = 484 * MiB;
constexpr int CW_BAR = 4096;

constexpr int LDS_BYTES = 147456;
constexpr int LDS_X = 131072;
constexpr int MISC_OFF = LDS_BYTES - 256;

typedef float f32x2_t __attribute__((ext_vector_type(2))); typedef __bf16 bf16x2_t __attribute__((ext_vector_type(2)));
__device__ __forceinline__ unsigned cvt_pk(float lo, float hi) { f32x2_t v = {lo, hi}; bf16x2_t b = __builtin_convertvector(v, bf16x2_t); return __builtin_bit_cast(unsigned, b); }
__device__ __forceinline__ float bf_lo(unsigned w) { return __uint_as_float(w << 16); }
__device__ __forceinline__ float bf_hi(unsigned w) { return __uint_as_float(w & 0xffff0000u); }
__device__ __forceinline__ float silu_f(float x) { return x * __builtin_amdgcn_rcpf(1.0f + __builtin_amdgcn_exp2f(-LOG2E * x)); }
__device__ __forceinline__ float sigmoid_f(float x) { return __builtin_amdgcn_rcpf(1.0f + __builtin_amdgcn_exp2f(-LOG2E * x)); }
__device__ __forceinline__ int crow(int r, int hi) { return (r & 3) + 8 * (r >> 2) + 4 * hi; }
#define LDS_WAIT() asm volatile("s_waitcnt lgkmcnt(0)" ::: "memory")
#define VM_WAIT() asm volatile("s_waitcnt vmcnt(0)" ::: "memory")

__device__ __forceinline__ unsigned off_a(unsigned row, unsigned ch) { return 2048u * (row >> 3) + 512u * (ch >> 2) + 64u * (row & 7) + 16u * ((ch & 3) ^ ((row >> 2) & 3)); }
__device__ __forceinline__ unsigned rr_base(int lane, int par) { const unsigned r = lane & 31, h = lane >> 5; return 2048u * (r >> 3) + 64u * (r & 7) + 16u * ((2u * par + h) ^ ((r >> 2) & 3)); }
__device__ __forceinline__ unsigned trn_base(int lane, int t) { const unsigned h = lane >> 5, blk = (lane >> 4) & 1, q = (lane & 15) >> 2, p = lane & 3;
    return 2048u * h + 64u * (4u * t + q) + 16u * ((2u * blk + (p >> 1)) ^ ((2u * h + t) & 3)) + 8u * (p & 1); }
__device__ __forceinline__ unsigned trp_base(int lane, int t) { const unsigned h = lane >> 5, blk = (lane >> 4) & 1, q = (lane & 15) >> 2, p = lane & 3;
    return 2048u * t + 64u * (4u * h + q) + 16u * ((2u * blk + (p >> 1)) ^ ((2u * t + h) & 3)) + 8u * (p & 1); }
typedef short v4i16_t __attribute__((ext_vector_type(4)));
__device__ __forceinline__ s16x4 vtr(const LAS unsigned char* p) { return __builtin_bit_cast(s16x4, __builtin_amdgcn_ds_read_tr16_b64_v4i16((LAS v4i16_t*)p)); }
__device__ __forceinline__ bf16x8 cat8(s16x4 a, s16x4 b) { return (bf16x8){a[0], a[1], a[2], a[3], b[0], b[1], b[2], b[3]}; }
__device__ __forceinline__ bf16x8 pack8f(const f32x16& x, int o) {
    u32x4 w = {cvt_pk(x[o + 0], x[o + 1]), cvt_pk(x[o + 2], x[o + 3]), cvt_pk(x[o + 4], x[o + 5]), cvt_pk(x[o + 6], x[o + 7])};
    return __builtin_bit_cast(bf16x8, w); }
__device__ __forceinline__ float swap32_max(float v) { auto rr = __builtin_amdgcn_permlane32_swap(__float_as_uint(v), __float_as_uint(v), false, false); return fmaxf(__uint_as_float(rr[0]), __uint_as_float(rr[1])); }
__device__ __forceinline__ float swap32_sum(float v) { auto rr = __builtin_amdgcn_permlane32_swap(__float_as_uint(v), __float_as_uint(v), false, false); return __uint_as_float(rr[0]) + __uint_as_float(rr[1]); }

namespace pg8 {
#define PG8_LAS __attribute__((address_space(3)))
typedef unsigned short bf16_t;
typedef short bf16x8 __attribute__((ext_vector_type(8)));
typedef float f32x4 __attribute__((ext_vector_type(4)));
typedef unsigned u32x4 __attribute__((ext_vector_type(4)));
constexpr int BM = 256, BK = 64, HALF = 128, HTB = HALF * BK * 2  , STAGE_BYTES = 8 * HTB, NXCD = 8, WGM = 8;

__host__ __device__ __forceinline__ int lds_byte(int r, int c) { const int st = (r >> 4) * 2 + (c >> 5), rr = r & 15, cc = c & 31, ob = rr * 64 + cc * 2; return st * 1024 + (ob ^ (((ob >> 9) & 1) << 5)); }
__host__ __device__ __forceinline__ void stage_rc(int b, int& R, int& C) { const int st = b / 1024, sb = b % 1024, swz = sb ^ (((sb >> 9) & 1) << 5); R = (st >> 1) * 16 + swz / 64; C = (st & 1) * 32 + (swz % 64) / 2; }
__host__ __device__ __forceinline__ int perm32(int rho) { const int n = rho >> 4, i = rho & 15; return 8 * (i >> 2) + 4 * n + (i & 3); }

struct Unit { int pm, pn; };
struct Gemm { const bf16_t* A; const bf16_t* Bt; int M, N, K, lda; };

struct StaticOrder {
    int nM, nN, nwg, G, c;
    __host__ __device__ void init(int M, int N, int G_, int c_) { nM = M / BM; nN = N / BM; nwg = nM * nN; G = G_; c = c_; }
    __host__ __device__ bool next(int i, Unit& u) const {
        const long L = (long)i * G + c; if (L >= nwg) return false;
        int wgid = (int)L; { const int q = nwg / NXCD, r = nwg % NXCD, xcd = wgid % NXCD, off = wgid / NXCD; wgid = (xcd < r ? xcd * (q + 1) : r * (q + 1) + (xcd - r) * q) + off; }
        const int nig = WGM * nN, gid = wgid / nig, fm = gid * WGM, gsz = (nM - fm) < WGM ? (nM - fm) : WGM;
        u.pm = fm + ((wgid % nig) % gsz); u.pn = (wgid % nig) / gsz; return true;
    }
    __device__ __forceinline__ void a_ready(const Unit&) const {}
    __device__ __forceinline__ void done(const Unit&) const {}
};

__device__ __forceinline__ unsigned cvt_pk_bf16(float lo, float hi) { return cvt_pk(lo, hi); }
typedef float f32x2 __attribute__((ext_vector_type(2)));
struct PanelStats {
    unsigned* xbuf;
    unsigned* cnt;
    unsigned* tmo;
    int ntn; float eps;
    unsigned code;
    __device__ __forceinline__ bool run(const f32x4 (&v)[2][2][4][2], const Unit& u, int wr, int wc, int fr, int fq, PG8_LAS unsigned char* lds, int wid, int lane) const {
        typedef float f32x2v __attribute__((ext_vector_type(2)));
        PG8_LAS f32x2v* P = (PG8_LAS f32x2v*)lds;
        PG8_LAS f32x2v* S = (PG8_LAS f32x2v*)(lds + 8192);
        PG8_LAS unsigned* flag = (PG8_LAS unsigned*)(lds + 8192 + 2048);
#pragma unroll
        for (int ai = 0; ai < 2; ++ai)
#pragma unroll
            for (int m = 0; m < 4; ++m) {
                float s = 0.f;
#pragma unroll
                for (int bj = 0; bj < 2; ++bj)
#pragma unroll
                    for (int n = 0; n < 2; ++n) { const f32x4 x = v[ai][bj][m][n]; s += (x[0] + x[1]) + (x[2] + x[3]); }
                s += __shfl_xor(s, 16); s += __shfl_xor(s, 32);
                const float mw = s * (1.0f / 64.0f); float q = 0.f;
#pragma unroll
                for (int bj = 0; bj < 2; ++bj)
#pragma unroll
                    for (int n = 0; n < 2; ++n) { const f32x4 d = v[ai][bj][m][n] - mw; q += (d[0] * d[0] + d[1] * d[1]) + (d[2] * d[2] + d[3] * d[3]); }
                q += __shfl_xor(q, 16); q += __shfl_xor(q, 32);
                if (fq == 0) P[(ai * HALF + wr * 64 + m * 16 + fr) * 4 + wc] = (f32x2v){mw, q};
            }
        asm volatile("s_waitcnt lgkmcnt(0)" ::: "memory"); __builtin_amdgcn_s_barrier(); asm volatile("" ::: "memory");
#if defined(BROKEN_EXCHANGE_NO_WAIT)
#warning BROKEN CONTROL BUILD: the row-statistics exchange does not wait; results are wrong by design
        if (blockIdx.x >= 64) { const long long t0_ = clock64(); while (clock64() - t0_ < 60000) __builtin_amdgcn_s_sleep(8); }
#endif
        const int row = wid * 32 + (lane & 31);
        if (lane < 32) {
            const f32x2v a = P[row * 4 + 0], b = P[row * 4 + 1], c = P[row * 4 + 2], d = P[row * 4 + 3];
            const float mt = (a.x + b.x + c.x + d.x) * 0.25f;
            const float da = a.x - mt, db = b.x - mt, dc = c.x - mt, dd = d.x - mt;
            const float m2 = (a.y + b.y) + (c.y + d.y) + 64.0f * ((da * da + db * db) + (dc * dc + dd * dd));
            unsigned long long* slot = (unsigned long long*)xbuf + ((size_t)(u.pm * BM + row) * 4 + u.pn);
            __hip_atomic_store(slot, ((unsigned long long)__float_as_uint(m2) << 32) | __float_as_uint(mt), __ATOMIC_RELAXED, __HIP_MEMORY_SCOPE_AGENT);
        }
        asm volatile("s_waitcnt vmcnt(0)" ::: "memory");
        if (lane == 0) __hip_atomic_fetch_add(cnt + 64 * u.pm, 1u, __ATOMIC_RELAXED, __HIP_MEMORY_SCOPE_AGENT);
        if (wid == 0) {
            bool dead = false; const unsigned long long t0 = __builtin_amdgcn_s_memrealtime(); const unsigned want = 8u * (unsigned)ntn;
            for (;;) {
#if defined(BROKEN_EXCHANGE_NO_WAIT)
                break;
#endif
                if ((unsigned)__builtin_amdgcn_readfirstlane(__hip_atomic_load(cnt + 64 * u.pm, __ATOMIC_RELAXED, __HIP_MEMORY_SCOPE_AGENT)) >= want) break;
                if (__builtin_amdgcn_s_memrealtime() - t0 > 2000000ull) {
                    if (lane == 0) { unsigned expect = 0u; __hip_atomic_compare_exchange_strong(tmo + 1, &expect, code | (unsigned)(u.pm & 0xff), __ATOMIC_RELAXED, __ATOMIC_RELAXED, __HIP_MEMORY_SCOPE_AGENT);
                                     __hip_atomic_store(tmo, 1u, __ATOMIC_RELAXED, __HIP_MEMORY_SCOPE_AGENT); }
                    dead = true; break; }
                __builtin_amdgcn_s_sleep(2);
            }
            __builtin_amdgcn_fence(__ATOMIC_ACQUIRE, "agent");
            if (lane == 0) flag[0] = dead ? 1u : 0u;
        }
        asm volatile("s_waitcnt vmcnt(0) lgkmcnt(0)" ::: "memory"); __builtin_amdgcn_s_barrier(); asm volatile("" ::: "memory");
        const bool bad = flag[0] != 0u;
        if (lane < 32) {
            const unsigned long long* slot = (const unsigned long long*)xbuf + (size_t)(u.pm * BM + row) * 4; float mt[4], m2[4]; float ms = 0.f;
#pragma unroll
            for (int t = 0; t < 4; ++t) { if (t < ntn) { const unsigned long long w = __hip_atomic_load(slot + t, __ATOMIC_RELAXED, __HIP_MEMORY_SCOPE_AGENT); mt[t] = __uint_as_float((unsigned)w); m2[t] = __uint_as_float((unsigned)(w >> 32)); } else { mt[t] = 0.f; m2[t] = 0.f; } ms += mt[t]; }
            const float mean = ms / (float)ntn; float q = 0.f;
#pragma unroll
            for (int t = 0; t < 4; ++t) if (t < ntn) { const float dm = mt[t] - mean; q += m2[t] + 256.0f * dm * dm; }
            S[row] = (f32x2v){mean, 1.0f / sqrtf(q / (256.0f * (float)ntn) + eps)};
        }
        asm volatile("s_waitcnt lgkmcnt(0)" ::: "memory"); __builtin_amdgcn_s_barrier(); asm volatile("" ::: "memory");
        return bad;
    }
};
template <bool ODD> struct EpiIn {
    static constexpr bool PERM = true, AFTER_DRAIN = false;
    bf16_t* P; const float* COS; const float* SIN;
    __device__ __forceinline__ void operator()(const f32x4 (&acc)[2][2][4][2], const Unit& u, int wr, int wc, int fr, int fq) const {
        const int row0 = u.pm * BM + wr * 64 + fr;
        int kind; float scale = 1.f;
        if (!ODD) { const int reg = u.pn >> 2; kind = reg < 2 ? 1 : (reg < 4 ? 2 : 0); if (reg == 3) scale = QK_SCALE; }
        else      { const int reg = u.pn >> 3; kind = reg < 2 ? 2 : 0; if (reg == 0) scale = QK_SCALE; }
        if (kind == 2) {
            const int hd = (wc >> 1) * 128, dlow = 32 * (wc & 1) + 8 * fq;
            bf16_t* pb = P + (size_t)u.pn * BM + hd + dlow;
#pragma unroll
            for (int ai = 0; ai < 2; ++ai)
#pragma unroll
                for (int m = 0; m < 4; ++m) { const int row = row0 + ai * HALF + m * 16, pos = row & (SEQ - 1);
                    const float* cp = COS + pos * 64 + dlow; const float* sp = SIN + pos * 64 + dlow;
                    const f32x4 c0 = *(const GAS f32x4*)cp, c1 = *(const GAS f32x4*)(cp + 4), s0 = *(const GAS f32x4*)sp, s1 = *(const GAS f32x4*)(sp + 4);
                    const f32x4 x10 = acc[ai][0][m][0], x11 = acc[ai][0][m][1], x20 = acc[ai][1][m][0], x21 = acc[ai][1][m][1];
                    const f32x4 a0 = (x10 * c0 - x20 * s0) * scale, a1 = (x11 * c1 - x21 * s1) * scale, b0 = (x20 * c0 + x10 * s0) * scale, b1 = (x21 * c1 + x11 * s1) * scale;
                    u32x4 w1, w2; w1.x = cvt_pk_bf16(a0[0], a0[1]); w1.y = cvt_pk_bf16(a0[2], a0[3]); w1.z = cvt_pk_bf16(a1[0], a1[1]); w1.w = cvt_pk_bf16(a1[2], a1[3]);
                    w2.x = cvt_pk_bf16(b0[0], b0[1]); w2.y = cvt_pk_bf16(b0[2], b0[3]); w2.z = cvt_pk_bf16(b1[0], b1[1]); w2.w = cvt_pk_bf16(b1[2], b1[3]);
                    bf16_t* rp = pb + (size_t)row * PP; *(GAS u32x4*)rp = w1; *(GAS u32x4*)(rp + 64) = w2;
                    asm volatile("" ::: "memory"); }
        } else {
            bf16_t* pb = P + (size_t)u.pn * BM + wc * 32 + 8 * fq;
#pragma unroll
            for (int ai = 0; ai < 2; ++ai)
#pragma unroll
                for (int m = 0; m < 4; ++m) { bf16_t* rp = pb + (size_t)(row0 + ai * HALF + m * 16) * PP;
#pragma unroll
                    for (int bj = 0; bj < 2; ++bj) { f32x4 v0 = acc[ai][bj][m][0], v1 = acc[ai][bj][m][1];
                        if (kind == 1) { v0 = (f32x4){silu_f(v0[0]), silu_f(v0[1]), silu_f(v0[2]), silu_f(v0[3])}; v1 = (f32x4){silu_f(v1[0]), silu_f(v1[1]), silu_f(v1[2]), silu_f(v1[3])}; }
                        u32x4 w; w.x = cvt_pk_bf16(v0[0], v0[1]); w.y = cvt_pk_bf16(v0[2], v0[3]); w.z = cvt_pk_bf16(v1[0], v1[1]); w.w = cvt_pk_bf16(v1[2], v1[3]);
                        *(GAS u32x4*)(rp + bj * HALF) = w; } }
        }
    }
};
struct EpiGate {
    static constexpr bool PERM = true, AFTER_DRAIN = false;
    bf16_t* P;
    __device__ __forceinline__ void operator()(const f32x4 (&acc)[2][2][4][2], const Unit& u, int wr, int wc, int fr, int fq) const {
        const int row0 = u.pm * BM + wr * 64 + fr;
        bf16_t* pb = P + (size_t)u.pn * BM + wc * 32 + 8 * fq;
#pragma unroll
        for (int ai = 0; ai < 2; ++ai)
#pragma unroll
            for (int m = 0; m < 4; ++m) { bf16_t* rp = pb + (size_t)(row0 + ai * HALF + m * 16) * PP;
#pragma unroll
                for (int bj = 0; bj < 2; ++bj) { const f32x4 v0 = acc[ai][bj][m][0], v1 = acc[ai][bj][m][1]; const u32x4 a = *(const GAS u32x4*)(rp + bj * HALF);
                    u32x4 w; w.x = cvt_pk_bf16(bf_lo(a.x) * silu_f(v0[0]), bf_hi(a.x) * silu_f(v0[1])); w.y = cvt_pk_bf16(bf_lo(a.y) * silu_f(v0[2]), bf_hi(a.y) * silu_f(v0[3]));
                    w.z = cvt_pk_bf16(bf_lo(a.z) * silu_f(v1[0]), bf_hi(a.z) * silu_f(v1[1])); w.w = cvt_pk_bf16(bf_lo(a.w) * silu_f(v1[2]), bf_hi(a.w) * silu_f(v1[3]));
                    *(GAS u32x4*)(rp + bj * HALF) = w; }
                if (m & 1) asm volatile("" ::: "memory"); }
    }
};
struct EpiOut {
    static constexpr bool PERM = false, AFTER_DRAIN = false;
    const float* xres; float* Z; int ldz;
    __device__ __forceinline__ void operator()(const f32x4 (&acc)[2][2][4][2], const Unit& u, int wr, int wc, int fr, int fq) const {
        const int row0 = u.pm * BM + wr * 64 + fr, col0 = u.pn * BM + wc * 32 + 4 * fq;
#pragma unroll
        for (int ai = 0; ai < 2; ++ai)
#pragma unroll
            for (int m = 0; m < 4; ++m) { const int row = row0 + ai * HALF + m * 16; const float* xr = xres + (size_t)row * DM + col0; float* zr = Z + (size_t)row * ldz + col0;
#pragma unroll
                for (int bj = 0; bj < 2; ++bj)
#pragma unroll
                    for (int n = 0; n < 2; ++n) { const f32x4 x = *(const GAS f32x4*)(xr + bj * HALF + n * 16); *(GAS f32x4*)(zr + bj * HALF + n * 16) = acc[ai][bj][m][n] + x * DN_ALPHA; }
                if (m & 1) asm volatile("" ::: "memory"); }
    }
};
template <class Epi, class Sched, bool ALIGN_EPI = false, bool SP2 = false>
__device__ __forceinline__ void gemm_phase(PG8_LAS unsigned char* lds, const Gemm g, const Sched& S, const Epi& E) {
    int tid_ = threadIdx.x; asm volatile("" : "+v"(tid_));
    const int tid = tid_, wid = __builtin_amdgcn_readfirstlane(tid >> 6), lane = tid & 63, wr = wid >> 2, wc = wid & 3, fr = lane & 15, fq = lane >> 4;
    const int K = g.K, nt = K / BK;
    unsigned voffA[2], voffB[2];
#pragma unroll
    for (int i = 0; i < 2; ++i) { int R, C; stage_rc(tid * 16 + i * 8192, R, C); const int Rb = Epi::PERM ? ((R & ~31) + perm32(R & 31)) : R;
        voffA[i] = (unsigned)(R * g.lda + C) * 2u; voffB[i] = (unsigned)(Rb * K + C) * 2u; }
    const size_t kstep = (size_t)(BK * 2);
    const size_t hstepA = (size_t)HALF * g.lda * 2, hstepB = (size_t)HALF * K * 2;
    const size_t tstepA = 2 * hstepA, tstepB = 2 * hstepB;
    const unsigned ldsw = (unsigned)wid * 1024u;
    const int aoff = lds_byte(wr * 64 + fr, fq * 8), boff = lds_byte(wc * 32 + fr, fq * 8);
#define PG8_SA(b, h) (((b) * 2 + (h)) * HTB)
#define PG8_SB(b, h) ((4 + (b) * 2 + (h)) * HTB)
#define PG8_STAGE(bufoff, gbase, voff) do { _Pragma("unroll") for (int _i = 0; _i < 2; ++_i) \
        __builtin_amdgcn_global_load_lds((const unsigned*)((const char*)(gbase) + (voff)[_i]), (PG8_LAS unsigned*)(lds + (bufoff) + ldsw + _i * 8192), 16, 0, 0); } while (0)
#define PG8_LDA(dst, b, h) do { _Pragma("unroll") for (int m = 0; m < 4; ++m) _Pragma("unroll") for (int k = 0; k < 2; ++k) dst[m][k] = *(const PG8_LAS bf16x8*)(lds + PG8_SA(b, h) + aoff + m * 2048 + k * 1024); } while (0)
#define PG8_LDB(dst, b, h) do { _Pragma("unroll") for (int n = 0; n < 2; ++n) _Pragma("unroll") for (int k = 0; k < 2; ++k) dst[n][k] = *(const PG8_LAS bf16x8*)(lds + PG8_SB(b, h) + boff + n * 2048 + k * 1024); } while (0)
#define PG8_MMA(ai, bj, At, Bt) do { __builtin_amdgcn_s_setprio(1); _Pragma("unroll") for (int m = 0; m < 4; ++m) _Pragma("unroll") for (int n = 0; n < 2; ++n) _Pragma("unroll") for (int k = 0; k < 2; ++k) \
        acc[ai][bj][m][n] = __builtin_amdgcn_mfma_f32_16x16x32_bf16(Bt[n][k], At[m][k], acc[ai][bj][m][n], 0, 0, 0); __builtin_amdgcn_s_setprio(0); } while (0)
#define PG8_WAIT_V(n) asm volatile("s_waitcnt vmcnt(" #n ")" ::: "memory")
#define PG8_WAIT_L(n) asm volatile("s_waitcnt lgkmcnt(" #n ")" ::: "memory")
#define PG8_BAR __builtin_amdgcn_s_barrier()
#define PG8_SCHED __builtin_amdgcn_sched_barrier(0)
    Unit cur, nxt; int ui = 0;
    if (!S.next(0, cur)) return;
    f32x4 acc[2][2][4][2];
#pragma unroll
    for (int a = 0; a < 2; ++a)
#pragma unroll
        for (int b = 0; b < 2; ++b)
#pragma unroll
            for (int m = 0; m < 4; ++m)
#pragma unroll
                for (int n = 0; n < 2; ++n) acc[a][b][m][n] = (f32x4){0.f, 0.f, 0.f, 0.f};
    bf16x8 At[4][2], B0[2][2], B1[2][2];
    const char* cA = (const char*)g.A + (size_t)cur.pm * tstepA; const char* cB = (const char*)g.Bt + (size_t)cur.pn * tstepB;
    S.a_ready(cur);
    if constexpr (SP2) {
        PG8_STAGE(PG8_SB(0, 0), cB, voffB); PG8_STAGE(PG8_SB(0, 1), cB + hstepB, voffB); PG8_STAGE(PG8_SA(0, 0), cA, voffA); PG8_STAGE(PG8_SA(0, 1), cA + hstepA, voffA);
        if (wr == 1) PG8_BAR;
        PG8_WAIT_V(2); PG8_BAR;
        PG8_STAGE(PG8_SB(1, 0), cB + kstep, voffB); PG8_STAGE(PG8_SA(1, 0), cA + kstep, voffA); PG8_STAGE(PG8_SB(1, 1), cB + hstepB + kstep, voffB);
        PG8_WAIT_V(6); PG8_BAR;
    } else {
        PG8_STAGE(PG8_SB(0, 0), cB, voffB); PG8_STAGE(PG8_SA(0, 0), cA, voffA); PG8_STAGE(PG8_SB(0, 1), cB + hstepB, voffB); PG8_STAGE(PG8_SA(0, 1), cA + hstepA, voffA);
        if (wr == 1) PG8_BAR;
        PG8_WAIT_V(4); PG8_BAR;
        PG8_STAGE(PG8_SB(1, 0), cB + kstep, voffB); PG8_STAGE(PG8_SA(1, 0), cA + kstep, voffA); PG8_STAGE(PG8_SB(1, 1), cB + hstepB + kstep, voffB);
        PG8_WAIT_V(6); PG8_BAR;
    }
    for (;;) {
        const bool has_next = S.next(ui + 1, nxt);
        const char* nA = has_next ? (const char*)g.A + (size_t)nxt.pm * tstepA : cA; const char* nB = has_next ? (const char*)g.Bt + (size_t)nxt.pn * tstepB : cB;
        for (int t = 0; t < nt; t += 2) {
            const bool last = (t == nt - 2);
            const char* a1 = cA + (size_t)(t + 1) * kstep;
            const char* a2 = last ? nA : cA + (size_t)(t + 2) * kstep; const char* b2 = last ? nB : cB + (size_t)(t + 2) * kstep;
            const char* a3 = a2 + kstep; const char* b3 = b2 + kstep;
            if (last && has_next) S.a_ready(nxt);
            if constexpr (SP2) {
            PG8_LDB(B0, 0, 0); PG8_LDB(B1, 0, 1); PG8_SCHED; PG8_LDA(At, 0, 0); PG8_STAGE(PG8_SA(1, 1), a1 + hstepA, voffA);
            PG8_WAIT_V(8); PG8_WAIT_L(0); PG8_BAR; PG8_MMA(0, 0, At, B0); PG8_MMA(0, 1, At, B1); PG8_BAR; PG8_SCHED;
            PG8_LDA(At, 0, 1); PG8_STAGE(PG8_SB(0, 0), b2, voffB); PG8_STAGE(PG8_SB(0, 1), b2 + hstepB, voffB); PG8_STAGE(PG8_SA(0, 0), a2, voffA);
            PG8_WAIT_V(8); PG8_WAIT_L(0); PG8_BAR; PG8_MMA(1, 0, At, B0); PG8_MMA(1, 1, At, B1); PG8_BAR; PG8_SCHED;
            PG8_LDB(B0, 1, 0); PG8_LDB(B1, 1, 1); PG8_SCHED; PG8_LDA(At, 1, 0); PG8_STAGE(PG8_SA(0, 1), a2 + hstepA, voffA);
            PG8_WAIT_V(8); PG8_WAIT_L(0); PG8_BAR; PG8_MMA(0, 0, At, B0); PG8_MMA(0, 1, At, B1); PG8_BAR; PG8_SCHED;
            PG8_LDA(At, 1, 1); PG8_STAGE(PG8_SB(1, 0), b3, voffB); PG8_STAGE(PG8_SB(1, 1), b3 + hstepB, voffB); PG8_STAGE(PG8_SA(1, 0), a3, voffA);
            PG8_WAIT_V(8); PG8_WAIT_L(0); PG8_BAR; PG8_MMA(1, 0, At, B0); PG8_MMA(1, 1, At, B1); PG8_BAR; PG8_SCHED;
            } else {
            PG8_LDB(B0, 0, 0); PG8_SCHED; PG8_LDA(At, 0, 0); PG8_STAGE(PG8_SA(1, 1), a1 + hstepA, voffA);
            PG8_WAIT_L(8); PG8_BAR; PG8_WAIT_L(0); PG8_MMA(0, 0, At, B0); PG8_BAR; PG8_SCHED;
            PG8_LDB(B1, 0, 1); PG8_STAGE(PG8_SB(0, 0), b2, voffB);
            PG8_BAR; PG8_WAIT_L(0); PG8_MMA(0, 1, At, B1); PG8_BAR;
            PG8_LDA(At, 0, 1); PG8_STAGE(PG8_SA(0, 0), a2, voffA);
            PG8_BAR; PG8_WAIT_L(0); PG8_MMA(1, 0, At, B0); PG8_BAR; PG8_SCHED;
            PG8_STAGE(PG8_SB(0, 1), b2 + hstepB, voffB);
            PG8_WAIT_V(6); PG8_BAR; PG8_MMA(1, 1, At, B1); PG8_BAR;
            PG8_LDB(B0, 1, 0); PG8_SCHED; PG8_LDA(At, 1, 0); PG8_STAGE(PG8_SA(0, 1), a2 + hstepA, voffA);
            PG8_WAIT_L(8); PG8_BAR; PG8_WAIT_L(0); PG8_MMA(0, 0, At, B0); PG8_BAR; PG8_SCHED;
            PG8_LDB(B1, 1, 1); PG8_STAGE(PG8_SB(1, 0), b3, voffB);
            PG8_BAR; PG8_WAIT_L(0); PG8_MMA(0, 1, At, B1); PG8_BAR;
            PG8_LDA(At, 1, 1); PG8_STAGE(PG8_SA(1, 0), a3, voffA);
            PG8_BAR; PG8_WAIT_L(0); PG8_MMA(1, 0, At, B0); PG8_BAR; PG8_SCHED;
            PG8_STAGE(PG8_SB(1, 1), b3 + hstepB, voffB);
            PG8_WAIT_V(6); PG8_BAR; PG8_MMA(1, 1, At, B1); PG8_BAR;
            }
        }
        if constexpr (ALIGN_EPI) { if (wr == 0) PG8_BAR; }
        if constexpr (!Epi::AFTER_DRAIN) { E(acc, cur, wr, wc, fr, fq); S.done(cur); }
        if (!has_next) break;
#pragma unroll
        for (int a = 0; a < 2; ++a)
#pragma unroll
            for (int b = 0; b < 2; ++b)
#pragma unroll
                for (int m = 0; m < 4; ++m)
#pragma unroll
                    for (int n = 0; n < 2; ++n) acc[a][b][m][n] = (f32x4){0.f, 0.f, 0.f, 0.f};
        cur = nxt; cA = nA; cB = nB; ++ui;
        if constexpr (ALIGN_EPI) { if (wr == 1) PG8_BAR; }
    }
    PG8_WAIT_V(0);
    if constexpr (!ALIGN_EPI) { if (wr == 0) PG8_BAR; }
    PG8_BAR;
    if constexpr (Epi::AFTER_DRAIN) { E.fused(acc, cur, wr, wc, fr, fq, lds, wid, lane); S.done(cur); }
#undef PG8_SA
#undef PG8_SB
#undef PG8_STAGE
#undef PG8_LDA
#undef PG8_LDB
#undef PG8_MMA
#undef PG8_WAIT_V
#undef PG8_WAIT_L
#undef PG8_BAR
#undef PG8_SCHED
}
}

typedef GAS unsigned gu32;
#define XB_TMO      128
#define XB_XCNT(j)  (256  + 64 * (j))
#define XB_XSUB(j)  (1280 + 64 * (j))
#define XB_XGEN(j)  (2304 + 64 * (j))
#define XB_TOP      3328
#define XB_TOPGEN   3392
#define XCD_BAR_WORDS 3456
#define XB_SPIN_CAP (1u << 18)

__device__ __forceinline__ unsigned xb_ld(unsigned* p)              { return __hip_atomic_load(p, __ATOMIC_RELAXED, __HIP_MEMORY_SCOPE_AGENT); }
__device__ __forceinline__ unsigned xb_add(unsigned* p, unsigned v) { return __hip_atomic_fetch_add(p, v, __ATOMIC_RELAXED, __HIP_MEMORY_SCOPE_AGENT); }
__device__ __forceinline__ unsigned xb_xcc_id() { return (unsigned)__builtin_amdgcn_s_getreg((3 << 11) | 20) & 0xFu; }
#define XB_SPIN(cond, bar) do { unsigned _sp = 0; while (cond) { __builtin_amdgcn_s_sleep(1); \
    if ((++_sp & 255u) == 0u) { if (xb_ld(&(bar)[XB_TMO])) break; if (_sp > XB_SPIN_CAP) { atomicAdd(&(bar)[XB_TMO], 1u); break; } } } } while (0)

struct XcdBarrier {
    unsigned* bar; unsigned x;
    volatile LAS unsigned* st;
};

__device__ __forceinline__ XcdBarrier xcd_barrier_post(unsigned* bar, volatile LAS unsigned* st) {
    XcdBarrier b; b.bar = bar; b.x = xb_xcc_id(); b.st = st;
    if (threadIdx.x == 0) (void)xb_add(&bar[XB_XCNT(b.x)], 1u);
    return b;
}
__device__ __forceinline__ void xcd_barrier_complete(unsigned* bar, unsigned x, unsigned& nloc, unsigned& nx) {
    const unsigned G = gridDim.x * gridDim.y * gridDim.z;
    unsigned sum, cnt, mine, sp = 0u;
    for (;;) {
        sum = 0u; cnt = 0u; mine = 0u;
#pragma unroll
        for (unsigned j = 0; j < 16; ++j) { const unsigned c = xb_ld(&bar[XB_XCNT(j)]); sum += c; cnt += (c > 0u) ? 1u : 0u; mine = (j == x) ? c : mine; }
        if (sum == G) break;
        __builtin_amdgcn_s_sleep(1);
        if ((++sp & 255u) == 0u) { if (xb_ld(&bar[XB_TMO])) break; if (sp > XB_SPIN_CAP) { atomicAdd(&bar[XB_TMO], 1u); break; } }
    }
    nloc = mine > 0u ? mine : 1u; nx = cnt > 0u ? cnt : 1u;
}

__device__ __forceinline__ void xcd_barrier(const XcdBarrier& b) {
    asm volatile("s_waitcnt vmcnt(0)" ::: "memory");
    __syncthreads();
    if (threadIdx.x == 0) {
        unsigned* bar = b.bar; asm volatile("" : "+s"(bar));
        __builtin_amdgcn_s_waitcnt(0);
        unsigned nloc = b.st[0], nx = b.st[1];
        if (nloc == 0u) { xcd_barrier_complete(bar, b.x, nloc, nx); b.st[0] = nloc; b.st[1] = nx; }
        const unsigned old = xb_add(&bar[XB_XSUB(b.x)], 1u);
        const unsigned gen = old / nloc;
        if (old + 1u == (gen + 1u) * nloc) {
            __builtin_amdgcn_fence(__ATOMIC_RELEASE, "agent");
            asm volatile("s_waitcnt vmcnt(0)" ::: "memory");
            const unsigned og = xb_add(&bar[XB_TOP], 1u);
            const unsigned tg = og / nx;
            if (og + 1u == (tg + 1u) * nx) xb_add(&bar[XB_TOPGEN], 1u);
            else XB_SPIN(xb_ld(&bar[XB_TOPGEN]) == tg, bar);
            __builtin_amdgcn_fence(__ATOMIC_ACQUIRE, "agent");
            xb_add(&bar[XB_XGEN(b.x)], 1u);
            asm volatile("s_waitcnt vmcnt(0)" ::: "memory");
        } else {
            XB_SPIN(xb_ld(&bar[XB_XGEN(b.x)]) == gen, bar);
            __builtin_amdgcn_fence(__ATOMIC_ACQUIRE, "agent");
            asm volatile("s_waitcnt vmcnt(0)" ::: "memory");
        }
    }
    __syncthreads();
}


constexpr int NWAVES = 8;
struct Frame {
    LAS unsigned char* lds;
    int tid, lane, wave, vcu, G;
};
__device__ __forceinline__ float wave_sum(float v) {
#pragma unroll
    for (int o = 1; o < 64; o <<= 1) v += __shfl_xor(v, o);
    return v;
}
__device__ __forceinline__ void transpose_item(const float* W, int N, bf16* WT, int K, int dst_row0, int src_col0, int k0, LAS float* scr, int lane) {
#pragma unroll 8
    for (int i = 0; i < 32; ++i) { const int kk = 2 * i + (lane >> 5); scr[kk * 33 + (lane & 31)] = W[(size_t)(k0 + kk) * N + src_col0 + (lane & 31)]; }
    LDS_WAIT(); asm volatile("" ::: "memory");
    const int c = lane & 7;
#pragma unroll
    for (int j = 0; j < 4; ++j) { const int n = (lane >> 3) + 8 * j; const LAS float* s = scr + (8 * c) * 33 + n;
        u32x4 o; o.x = cvt_pk(s[0 * 33], s[1 * 33]); o.y = cvt_pk(s[2 * 33], s[3 * 33]); o.z = cvt_pk(s[4 * 33], s[5 * 33]); o.w = cvt_pk(s[6 * 33], s[7 * 33]);
        *(GAS u32x4*)(WT + (size_t)(dst_row0 + n) * K + k0 + 8 * c) = o; }
    LDS_WAIT(); asm volatile("" ::: "memory");
}
__device__ __forceinline__ int win_src_even(int n) {
    const int tile = n >> 8, p = n & 255, reg = tile >> 2, t = tile & 3;
    const int base = reg == 0 ? 3072 : reg == 1 ? 5120 : reg == 2 ? 0 : reg == 3 ? 1024 : reg == 4 ? 2048 : 4096;
    if (reg == 2 || reg == 3) { const int bj = p >> 7, j = p & 127; return base + (2 * t + (j >> 6)) * 128 + (j & 63) + 64 * bj; }
    return base + 256 * t + p;
}
__device__ __forceinline__ int win_src_odd(int n) {
    if (n >= 4096) return n;
    const int tile = n >> 8, p = n & 255, reg = tile >> 3, t = tile & 7, bj = p >> 7, j = p & 127;
    return reg * 2048 + (2 * t + (j >> 6)) * 128 + (j & 63) + 64 * bj;
}
template <bool ODD> __device__ __forceinline__ void conv_win(Frame& F, const float* W, bf16* WT) {
    LAS float* scr = (LAS float*)(F.lds + F.wave * 16384);
    int lane_o = F.lane; asm volatile("" : "+v"(lane_o));
    constexpr int N = ODD ? 8192 : 6144, NB = N / 32, NITEMS = 16 * NB;
    const int gw = F.vcu * NWAVES + F.wave, NGW = F.G * NWAVES;
    for (int it = gw; it < NITEMS; it += NGW) { const int kb = it / NB, nb = it % NB; const int src = ODD ? win_src_odd(32 * nb) : win_src_even(32 * nb);
        transpose_item(W, N, WT, 1024, 32 * nb, src, 64 * kb, scr, lane_o); }
}

__device__ __forceinline__ void sincos_d(float angf, float& s_out, float& c_out) {
    const double a = (double)angf; const double k = __builtin_rint(a * 0.63661977236758134308); const double r = (a - k * 1.57079632679489655800) - k * 6.12323399573676603587e-17;
    const double r2 = r * r;
    const double s = r * (1.0 + r2 * (-1.0 / 6 + r2 * (1.0 / 120 + r2 * (-1.0 / 5040 + r2 * (1.0 / 362880 + r2 * (-1.0 / 39916800 + r2 * (1.0 / 6227020800.0)))))));
    const double c = 1.0 + r2 * (-0.5 + r2 * (1.0 / 24 + r2 * (-1.0 / 720 + r2 * (1.0 / 40320 + r2 * (-1.0 / 3628800 + r2 * (1.0 / 479001600.0 + r2 * (-1.0 / 87178291200.0)))))));
    const int q = (int)((long long)k & 3);
    const double ss = (q == 0) ? s : (q == 1) ? c : (q == 2) ? -s : -c;
    const double cc = (q == 0) ? c : (q == 1) ? -s : (q == 2) ? -c : s;
    s_out = (float)ss; c_out = (float)cc;
}

struct Args { const float* in[23]; float* out; unsigned char* ws; int ph_lo, ph_hi; };

__device__ __forceinline__ void p0_prologue(Frame& F, const Args& A) {
    unsigned char* ws = A.ws;
    const int gw = F.vcu * NWAVES + F.wave, NGW = F.G * NWAVES, gt = gw * 64 + F.lane, NGT = NGW * 64;
    LAS float* scr = (LAS float*)(F.lds + F.wave * 16384);
    { const float* x = A.in[0]; bf16* x16 = (bf16*)(ws + WS_X16);
      for (size_t i = (size_t)gt; i < (size_t)MTOK * DM / 8; i += NGT) { const f32x4 a = *(const GAS f32x4*)(x + i * 8), b = *(const GAS f32x4*)(x + i * 8 + 4);
          u32x4 w; w.x = cvt_pk(a[0], a[1]); w.y = cvt_pk(a[2], a[3]); w.z = cvt_pk(b[0], b[1]); w.w = cvt_pk(b[2], b[3]); *(GAS u32x4*)(x16 + i * 8) = w; } }
    { float* COS = (float*)(ws + WS_ROPE); float* SIN = COS + SEQ * 64;
      for (int i = gt; i < SEQ * 64; i += NGT) { const int pos = i >> 6, f = i & 63;
          double w = 1.0; { double bpow = 0.86596432336006535; int e = f; while (e) { if (e & 1) w *= bpow; bpow *= bpow; e >>= 1; } }
          const float ang = (float)pos * (float)w; float s, c; sincos_d(ang, s, c); COS[i] = c; SIN[i] = s; } }
    if (gw < 2) { const int j = gw; const float* q1 = A.in[15] + j * 128, *k1 = A.in[16] + j * 128, *q2 = A.in[17] + j * 128, *k2 = A.in[18] + j * 128;
        float s1 = q1[F.lane] * k1[F.lane] + q1[F.lane + 64] * k1[F.lane + 64], s2 = q2[F.lane] * k2[F.lane] + q2[F.lane + 64] * k2[F.lane + 64];
        s1 = wave_sum(s1); s2 = wave_sum(s2);
        const float linit = (j == 0) ? 0.35550906759096927f : 0.55605820415654060f;
        if (F.lane == 0) { float* par = (float*)(ws + WS_PAR); par[j] = __expf(s1) - __expf(s2) + linit; } }
    conv_win<false>(F, A.in[1], (bf16*)(ws + WS_WIN));
    for (int it = gw; it < 4 * 1024; it += NGW) { const int l = it >> 10, r = it & 1023, kb = r >> 5, nb = r & 31;
        const float* W = (l & 1) ? A.in[20] + (size_t)(l >> 1) * 2048 * 1024 : A.in[11] + (size_t)(l >> 1) * 2048 * 1024;
        transpose_item(W, 1024, (bf16*)(ws + WS_WOUT) + (size_t)l * 2048 * 1024, 2048, 32 * nb, 32 * nb, 64 * kb, scr, F.lane); }
    for (int it = gw; it < 256; it += NGW) { const int mat = it >> 3, r = it & 7, kb = r >> 2, nb = r & 3;
        const int lj = mat >> 4, gate = (mat >> 3) & 1, blk = mat & 7; const float* W = A.in[gate ? 6 : 4] + ((size_t)lj * 8 + blk) * 128 * 128;
        transpose_item(W, 128, (bf16*)(ws + WS_WG) + (size_t)mat * 128 * 128, 128, 32 * nb, 32 * nb, 64 * kb, scr, F.lane); }
}

__device__ __forceinline__ void ln_phase(Frame& F, const float* Z, int ldz, const float* g, const float* bta, float* out, bf16* x16) {
    const int gw = F.vcu * NWAVES + F.wave, NGW = F.G * NWAVES;
    int lane_o = F.lane; asm volatile("" : "+v"(lane_o));
    f32x4 gv[4], bv[4];
#pragma unroll
    for (int j = 0; j < 4; ++j) { gv[j] = *(const GAS f32x4*)(g + 4 * lane_o + 256 * j); bv[j] = *(const GAS f32x4*)(bta + 4 * lane_o + 256 * j); }
    for (int m = gw; m < MTOK; m += NGW) {
        const GAS f32x4* zr = (const GAS f32x4*)(Z + (size_t)m * ldz) + lane_o;
        f32x4 v[4]; float s = 0.f;
#pragma unroll
        for (int j = 0; j < 4; ++j) { v[j] = zr[64 * j]; s += (v[j].x + v[j].y) + (v[j].z + v[j].w); }
        const float mean = wave_sum(s) * (1.f / DM); float s2 = 0.f;
#pragma unroll
        for (int j = 0; j < 4; ++j) { v[j] = v[j] - mean; s2 += (v[j].x * v[j].x + v[j].y * v[j].y) + (v[j].z * v[j].z + v[j].w * v[j].w); }
        const float rstd = 1.f / sqrtf(wave_sum(s2) * (1.f / DM) + NORM_EPS);
        GAS f32x4* o4 = (GAS f32x4*)(out + (size_t)m * DM) + lane_o; GAS u32x2* o2 = (GAS u32x2*)(x16 + (size_t)m * DM) + lane_o;
#pragma unroll
        for (int j = 0; j < 4; ++j) { const f32x4 y = v[j] * rstd * gv[j] + bv[j]; o4[64 * j] = y; u32x2 w; w.x = cvt_pk(y.x, y.y); w.y = cvt_pk(y.z, y.w); o2[64 * j] = w; }
    }
}

__device__ __forceinline__ void retention_unit(LAS unsigned char* lds, bf16* P, const float* gng, const float* gnb, int b, int h, bool st = true) {
    int tid_ = threadIdx.x; asm volatile("" : "+v"(tid_));
    const int tid = tid_, lane = tid & 63, wid = __builtin_amdgcn_readfirstlane(tid >> 6), r32 = lane & 31, hq = lane >> 5;
    const int ib = wid & 3, eh = wid >> 2;
    LAS unsigned char* QI = lds; LAS unsigned char* KI = lds + 32768; LAS unsigned char* VI = lds + 65536; LAS unsigned char* RI = lds + 98304;
    LAS float* ST = (LAS float*)(lds + LDS_X);
    LAS float* GN = (LAS float*)(lds + LDS_X + 2048);
    float lg; { const double x = 1.0 / (double)(1 << (5 + h)); double t = x, s = 0.0;
#pragma unroll
        for (int k = 1; k <= 10; ++k) { s += t / k; t *= x; } lg = (float)(-s * 1.4426950408889634); }
    const float g128 = __builtin_amdgcn_exp2f(128.f * lg);
    if (tid < 128) { GN[tid] = gng[h * 128 + tid]; GN[128 + tid] = gnb[h * 128 + tid]; }
    const unsigned rb0 = rr_base(lane, 0), rb1 = rr_base(lane, 1), tn0 = trn_base(lane, 0), tn1 = trn_base(lane, 1), tp0 = trp_base(lane, 0), tp1 = trp_base(lane, 1);
    f32x16 Racc[2]; Racc[0] = f32x16{}; Racc[1] = f32x16{};
    const int db = wid & 3, ebr = 2 * (wid >> 2);
    bf16* Pb = P + (size_t)b * SEQ * PP;
    u32x4 sq[4], sk[4], sv[4]; u32x2 sg[2][4];
    const unsigned voffS = (unsigned)(((tid >> 4) * PP + 8 * (tid & 15)) * 2);
    const unsigned voffG = (unsigned)((r32 * PP + 4 * hq) * 2);
#define RET_LOAD(nn) do { const GAS char* bs_ = (const GAS char*)(Pb + (size_t)(128 * (nn)) * PP + 128 * h); _Pragma("unroll") for (int k = 0; k < 4; ++k) { const GAS char* bk_ = bs_ + (size_t)k * 32 * PP * 2; \
        sq[k] = *(const GAS u32x4*)(bk_ + 4096 + voffS); sk[k] = *(const GAS u32x4*)(bk_ + 6144 + voffS); sv[k] = *(const GAS u32x4*)(bk_ + 8192 + voffS); } } while (0)
#define RET_LOADG(nn) do { const GAS char* bg_ = (const GAS char*)(Pb + (size_t)(128 * (nn) + 32 * ib) * PP + 128 * h + 64 * eh); _Pragma("unroll") for (int e2 = 0; e2 < 2; ++e2) _Pragma("unroll") for (int g4 = 0; g4 < 4; ++g4) sg[e2][g4] = *(const GAS u32x2*)(bg_ + (32 * e2 + 8 * g4) * 2 + voffG); } while (0)
    RET_LOAD(0); RET_LOADG(0);
    for (int n = 0; n < 16; ++n) {
        bf16* Pc = Pb + (size_t)(128 * n) * PP;
#pragma unroll
        for (int k = 0; k < 4; ++k) { const int id = tid + 512 * k, row = id >> 4, ch = id & 15;
            const u32x4 kk = sk[k];
            const float f = __builtin_amdgcn_exp2f(-(float)(row + 1) * lg);
            u32x4 kd; kd.x = cvt_pk(bf_lo(kk.x) * f, bf_hi(kk.x) * f); kd.y = cvt_pk(bf_lo(kk.y) * f, bf_hi(kk.y) * f); kd.z = cvt_pk(bf_lo(kk.z) * f, bf_hi(kk.z) * f); kd.w = cvt_pk(bf_lo(kk.w) * f, bf_hi(kk.w) * f);
            const unsigned o = off_a(row, ch);
            *(LAS u32x4*)(QI + o) = sq[k]; *(LAS u32x4*)(KI + o) = kd; *(LAS u32x4*)(VI + o) = sv[k];
            if (n == 0) *(LAS u32x4*)(RI + o) = (u32x4){0u, 0u, 0u, 0u}; }
        __syncthreads();
        bf16x8 qf[8];
#pragma unroll
        for (int s = 0; s < 8; ++s) qf[s] = *(const LAS bf16x8*)(QI + ib * 8192 + ((s & 1) ? rb1 : rb0) + 512 * (s >> 1));
        f32x16 acc[2]; acc[0] = f32x16{}; acc[1] = f32x16{};
#pragma unroll
        for (int ks = 0; ks < 8; ++ks)
#pragma unroll
            for (int e2 = 0; e2 < 2; ++e2) { const int c = 2 * eh + e2;
                const bf16x8 a = cat8(vtr(RI + tn0 + 4096 * ks + 512 * c), vtr(RI + tn1 + 4096 * ks + 512 * c));
                acc[e2] = __builtin_amdgcn_mfma_f32_32x32x16_bf16(a, qf[ks], acc[e2], 0, 0, 0); }
        for (int jb = 0; jb <= ib; ++jb) {
            f32x16 x = f32x16{};
#pragma unroll
            for (int ks = 0; ks < 8; ++ks) { const bf16x8 a = *(const LAS bf16x8*)(KI + jb * 8192 + ((ks & 1) ? rb1 : rb0) + 512 * (ks >> 1));
                x = __builtin_amdgcn_mfma_f32_32x32x16_bf16(a, qf[ks], x, 0, 0, 0); }
            if (jb == ib) {
#pragma unroll
                for (int r = 0; r < 16; ++r) if (crow(r, hq) > r32) x[r] = 0.f; }
            const bf16x8 xb0 = pack8f(x, 0), xb1 = pack8f(x, 8);
#pragma unroll
            for (int e2 = 0; e2 < 2; ++e2) { const int c = 2 * eh + e2;
                const bf16x8 a0 = cat8(vtr(VI + jb * 8192 + tp0 + 512 * c), vtr(VI + jb * 8192 + tp1 + 512 * c));
                const bf16x8 a1 = cat8(vtr(VI + jb * 8192 + tp0 + 4096 + 512 * c), vtr(VI + jb * 8192 + tp1 + 4096 + 512 * c));
                acc[e2] = __builtin_amdgcn_mfma_f32_32x32x16_bf16(a0, xb0, acc[e2], 0, 0, 0);
                acc[e2] = __builtin_amdgcn_mfma_f32_32x32x16_bf16(a1, xb1, acc[e2], 0, 0, 0); }
        }
        { const float sc = __builtin_amdgcn_exp2f((float)(32 * ib + r32 + 1) * lg); float s = 0.f, ss = 0.f;
#pragma unroll
          for (int e2 = 0; e2 < 2; ++e2)
#pragma unroll
              for (int r = 0; r < 16; ++r) { const float v = acc[e2][r] * sc; acc[e2][r] = v; s += v; ss += v * v; }
          s = swap32_sum(s); ss = swap32_sum(ss);
          if (hq == 0) { ST[(eh * 128 + 32 * ib + r32) * 2] = s; ST[(eh * 128 + 32 * ib + r32) * 2 + 1] = ss; } }
        if (n + 1 < 16) RET_LOAD(n + 1);
#pragma unroll
        for (int ks = 0; ks < 8; ++ks) { const bf16x8 bq = cat8(vtr(KI + tn0 + 4096 * ks + 512 * db), vtr(KI + tn1 + 4096 * ks + 512 * db));
#pragma unroll
            for (int e2 = 0; e2 < 2; ++e2) { const bf16x8 a = cat8(vtr(VI + tn0 + 4096 * ks + 512 * (ebr + e2)), vtr(VI + tn1 + 4096 * ks + 512 * (ebr + e2)));
                Racc[e2] = __builtin_amdgcn_mfma_f32_32x32x16_bf16(a, bq, Racc[e2], 0, 0, 0); } }
#pragma unroll
        for (int e2 = 0; e2 < 2; ++e2)
#pragma unroll
            for (int r = 0; r < 16; ++r) Racc[e2][r] *= g128;
        __syncthreads();
#pragma unroll
        for (int e2 = 0; e2 < 2; ++e2)
#pragma unroll
            for (int g4 = 0; g4 < 4; ++g4) { u32x2 w; w.x = cvt_pk(Racc[e2][4 * g4], Racc[e2][4 * g4 + 1]); w.y = cvt_pk(Racc[e2][4 * g4 + 2], Racc[e2][4 * g4 + 3]);
                *(LAS u32x2*)(RI + off_a(32 * db + r32, 4 * (ebr + e2) + g4) + 8 * hq) = w; }
        { const int i = 32 * ib + r32; const float s = ST[i * 2] + ST[(128 + i) * 2], ss = ST[i * 2 + 1] + ST[(128 + i) * 2 + 1];
          const float mean = s * (1.f / 128.f), var = fmaxf(ss * (1.f / 128.f) - mean * mean, 0.f), rstd = 1.f / sqrtf(var + NORM_EPS);
          GAS char* op = (GAS char*)(Pc + (size_t)(32 * ib) * PP + 128 * h + 64 * eh);
#pragma unroll
          for (int e2 = 0; e2 < 2; ++e2)
#pragma unroll
              for (int g4 = 0; g4 < 4; ++g4) { const int e0 = 64 * eh + 32 * e2 + 8 * g4 + 4 * hq; const f32x4 gg = *(const LAS f32x4*)(GN + e0), gb = *(const LAS f32x4*)(GN + 128 + e0);
                  const u32x2 gt = sg[e2][g4];
                  const float o0 = ((acc[e2][4 * g4 + 0] - mean) * rstd * gg[0] + gb[0]) * bf_lo(gt.x), o1 = ((acc[e2][4 * g4 + 1] - mean) * rstd * gg[1] + gb[1]) * bf_hi(gt.x);
                  const float o2 = ((acc[e2][4 * g4 + 2] - mean) * rstd * gg[2] + gb[2]) * bf_lo(gt.y), o3 = ((acc[e2][4 * g4 + 3] - mean) * rstd * gg[3] + gb[3]) * bf_hi(gt.y);
                  u32x2 w; w.x = cvt_pk(o0, o1); w.y = cvt_pk(o2, o3); if (st) *(GAS u32x2*)(op + (32 * e2 + 8 * g4) * 2 + voffG) = w; } }
        if (n + 1 < 16) RET_LOADG(n + 1);
    }
#undef RET_LOAD
#undef RET_LOADG
    __syncthreads();
}

__device__ __forceinline__ float softplus_f(float x) {
    if (x > 20.f) return x;
    const float y = __builtin_amdgcn_exp2f(x * LOG2E);
    if (y < 0.25f) { return y * (1.f + y * (-0.5f + y * (1.f / 3 + y * (-0.25f + y * (0.2f + y * (-1.f / 6 + y * (1.f / 7 + y * (-0.125f + y * (1.f / 9 + y * (-0.1f)))))))))); }
    return __builtin_amdgcn_logf(1.f + y) * 0.6931471805599453f;
}
__device__ __forceinline__ void lru_unit(LAS unsigned char* lds, bf16* P, const bf16* WG, const float* conv_w, const float* conv_b, const float* ba, const float* bx, const float* lam, int b, int g, bool st = true) {
    int tid_ = threadIdx.x; asm volatile("" : "+v"(tid_));
    const int tid = tid_, lane = tid & 63, wid = __builtin_amdgcn_readfirstlane(tid >> 6), r32 = lane & 31, hq = lane >> 5;
    const int tb = wid & 1, jb = wid >> 1;
    LAS unsigned char* XC = lds;
    LAS float* AF = (LAS float*)(lds + 16384);
    LAS float* UF = (LAS float*)(lds + 49152);
    LAS unsigned short* SGO = (LAS unsigned short*)(lds + 81920);
    LAS float* COMP = (LAS float*)(lds + 114688);
    LAS float* HC = (LAS float*)(lds + 118784);
    LAS float* CW = (LAS float*)(lds + 119808);
    for (int i = tid; i < 640; i += 512) { const int w = i >> 7, c = i & 127; CW[i] = (w < 4) ? conv_w[w * 1024 + 128 * g + c] : conv_b[128 * g + c]; }
    if (tid < 256) HC[tid] = 0.f;
    const unsigned rb0 = rr_base(lane, 0), rb1 = rr_base(lane, 1);
    bf16x8 waf[8], wxf[8];
    { const bf16* wa = WG + (size_t)g * 16384 + (size_t)(32 * jb + r32) * 128 + 8 * hq; const bf16* wx = wa + 8 * 16384;
#pragma unroll
      for (int ks = 0; ks < 8; ++ks) { waf[ks] = *(const GAS bf16x8*)(wa + 16 * ks); wxf[ks] = *(const GAS bf16x8*)(wx + 16 * ks); } }
    const int cj = 128 * g + 32 * jb + r32;
    const float kba = -LOG2E * ba[cj], kbx = -LOG2E * bx[cj], k1 = -8.f * LOG2E * softplus_f(-lam[cj]);
    bf16* Pb = P + (size_t)b * SEQ * PP;
    const int oct = tid & 15, tp = tid >> 4;
    const int sc_c = tid & 127, sc_seg = tid >> 7;
    const unsigned voffI = (unsigned)(((2 * tp) * PP + 128 * g + 8 * oct) * 2);
    const GAS char* Pbc = (const GAS char*)Pb;
    u32x4 xr[5], gr[2];
#pragma unroll
    for (int k = 0; k < 5; ++k) { const int t = 2 * tp - 3 + k; xr[k] = (t >= 0) ? *(const GAS u32x4*)(Pbc + (size_t)(k - 3) * PP * 2 + 10240 + voffI) : (u32x4){0u, 0u, 0u, 0u}; }
    gr[0] = *(const GAS u32x4*)(Pbc + 2048 + voffI); gr[1] = *(const GAS u32x4*)(Pbc + (size_t)PP * 2 + 2048 + voffI);
    __syncthreads();
    for (int n = 0; n < 32; ++n) {
        LAS unsigned short* SG = SGO + (n & 1) * 8192;
        { f32x4 o[2][2];
          { const f32x4 b0 = *(const LAS f32x4*)(CW + 512 + 8 * oct), b1 = *(const LAS f32x4*)(CW + 512 + 8 * oct + 4); o[0][0] = b0; o[0][1] = b1; o[1][0] = b0; o[1][1] = b1; }
#pragma unroll
          for (int w = 0; w < 4; ++w) { const f32x4 w0 = *(const LAS f32x4*)(CW + 128 * w + 8 * oct), w1 = *(const LAS f32x4*)(CW + 128 * w + 8 * oct + 4);
#pragma unroll
              for (int rr = 0; rr < 2; ++rr) { const u32x4 x = xr[rr + w];
                  o[rr][0] += w0 * (f32x4){bf_lo(x.x), bf_hi(x.x), bf_lo(x.y), bf_hi(x.y)}; o[rr][1] += w1 * (f32x4){bf_lo(x.z), bf_hi(x.z), bf_lo(x.w), bf_hi(x.w)}; } }
#pragma unroll
          for (int rr = 0; rr < 2; ++rr) { const int t = 2 * tp + rr;
              u32x4 w; w.x = cvt_pk(o[rr][0][0], o[rr][0][1]); w.y = cvt_pk(o[rr][0][2], o[rr][0][3]); w.z = cvt_pk(o[rr][1][0], o[rr][1][1]); w.w = cvt_pk(o[rr][1][2], o[rr][1][3]);
              *(LAS u32x4*)(XC + off_a(t, oct)) = w; *(LAS u32x4*)(SG + t * 128 + 8 * oct) = gr[rr]; }
          if (n + 1 < 32) { const GAS char* pn = Pbc + (size_t)(64 * (n + 1)) * PP * 2;
#pragma unroll
              for (int k = 0; k < 5; ++k) xr[k] = *(const GAS u32x4*)(pn + (long)(k - 3) * PP * 2 + 10240 + voffI);
              gr[0] = *(const GAS u32x4*)(pn + 2048 + voffI); gr[1] = *(const GAS u32x4*)(pn + (size_t)PP * 2 + 2048 + voffI); } }
        __syncthreads();
        if (n > 0 && st) { LAS unsigned short* SO = SGO + ((n - 1) & 1) * 8192; GAS char* po = (GAS char*)Pb + (size_t)(64 * (n - 1)) * PP * 2;
#pragma unroll
            for (int rr = 0; rr < 2; ++rr) *(GAS u32x4*)(po + (size_t)rr * PP * 2 + 2048 + voffI) = *(const LAS u32x4*)(SO + (2 * tp + rr) * 128 + 8 * oct); }
        { f32x16 ga = f32x16{}, gx = f32x16{};
#pragma unroll
          for (int ks = 0; ks < 8; ++ks) { const bf16x8 a = *(const LAS bf16x8*)(XC + tb * 8192 + ((ks & 1) ? rb1 : rb0) + 512 * (ks >> 1));
              ga = __builtin_amdgcn_mfma_f32_32x32x16_bf16(a, waf[ks], ga, 0, 0, 0); gx = __builtin_amdgcn_mfma_f32_32x32x16_bf16(a, wxf[ks], gx, 0, 0, 0); }
          const int c = 32 * jb + r32;
#pragma unroll
          for (int r = 0; r < 16; ++r) { const int t = 32 * tb + crow(r, hq);
              const float xc = __uint_as_float((unsigned)*(const LAS unsigned short*)(XC + off_a(t, c >> 3) + 2 * (c & 7)) << 16);
              const float rg = __builtin_amdgcn_rcpf(1.f + __builtin_amdgcn_exp2f(fmaf(ga[r], -LOG2E, kba))), ig = __builtin_amdgcn_rcpf(1.f + __builtin_amdgcn_exp2f(fmaf(gx[r], -LOG2E, kbx)));
              const float xl = rg * k1, a = __builtin_amdgcn_exp2f(xl), z = xl * 1.3862943611198906f;
              const float oms = -z * fmaf(z, fmaf(z, 1.f / 6, 0.5f), 1.f);
              const float om = (z > -0.06f) ? oms : fmaf(-a, a, 1.f);
              AF[t * 128 + c] = a; UF[t * 128 + c] = xc * ig * __builtin_amdgcn_sqrtf(om); } }
        __syncthreads();
        { float A = 1.f, B = 0.f;
#pragma unroll
          for (int t = 0; t < 16; ++t) { const float a = AF[(16 * sc_seg + t) * 128 + sc_c], u = UF[(16 * sc_seg + t) * 128 + sc_c]; B = a * B + u; A = a * A; }
          COMP[(sc_seg * 128 + sc_c) * 2] = A; COMP[(sc_seg * 128 + sc_c) * 2 + 1] = B; }
        __syncthreads();
        { float hv = HC[(n & 1) * 128 + sc_c];
          for (int s = 0; s < sc_seg; ++s) hv = COMP[(s * 128 + sc_c) * 2] * hv + COMP[(s * 128 + sc_c) * 2 + 1];
#pragma unroll
          for (int t = 0; t < 16; ++t) { const int tt = 16 * sc_seg + t; const float a = AF[tt * 128 + sc_c], u = UF[tt * 128 + sc_c]; hv = a * hv + u;
              const float o = hv * __uint_as_float((unsigned)SG[tt * 128 + sc_c] << 16); SG[tt * 128 + sc_c] = (unsigned short)(cvt_pk(o, 0.f) & 0xffffu); }
          if (sc_seg == 3) HC[((n + 1) & 1) * 128 + sc_c] = hv; }
    }
    __syncthreads();
    if (st) { LAS unsigned short* SO = SGO + 8192; GAS char* po = (GAS char*)Pb + (size_t)(64 * 31) * PP * 2;
#pragma unroll
        for (int rr = 0; rr < 2; ++rr) *(GAS u32x4*)(po + (size_t)rr * PP * 2 + 2048 + voffI) = *(const LAS u32x4*)(SO + (2 * tp + rr) * 128 + 8 * oct); }
    __syncthreads();
}

constexpr int AT_STAGE = 65536;
__device__ __forceinline__ void glds16(const GAS void* gsrc, unsigned lds_dst) { unsigned keep;
    asm volatile("s_mov_b32 %0, m0\n\ts_mov_b32 m0, %2\n\ts_nop 0\n\tglobal_load_lds_dwordx4 %1, off\n\ts_mov_b32 m0, %0" : "=&s"(keep) : "v"(gsrc), "s"(lds_dst) : "memory"); }
__device__ __forceinline__ void attn_dma(unsigned lds0, const bf16* Pb, int h, int tile, int stage, int wid, int lane) {
    const int img = wid >> 1, jb0 = 8 * (wid & 1);
    const int colbase = (img < 2) ? 2048 + (2 * h + img) * 128 : 4096 + 256 * h + 128 * (img - 2);
    const GAS char* src0 = (const GAS char*)(Pb + (size_t)(64 * tile) * PP + colbase);
    const unsigned dst0 = lds0 + stage * AT_STAGE + img * 16384 + jb0 * 1024;
#pragma unroll
    for (int k = 0; k < 8; ++k) { const int j = jb0 + k; const int rowp = 8 * (j >> 1) + ((lane >> 2) & 7), chg = 2 * (j & 1) + (lane >> 5), ch = 4 * chg + ((lane & 3) ^ ((rowp >> 2) & 3));
        glds16(src0 + (unsigned)((rowp * PP + 8 * ch) * 2), (unsigned)__builtin_amdgcn_readfirstlane(dst0 + k * 1024)); }
}
__device__ __forceinline__ void attn_qblock(LAS unsigned char* lds, bf16* P, const float* subg, float lamv, float omli, int b, int h, int qb, bool st = true) {
    int tid_ = threadIdx.x; asm volatile("" : "+v"(tid_));
    const int tid = tid_, lane = tid & 63, wid = __builtin_amdgcn_readfirstlane(tid >> 6), r32 = lane & 31, hq = lane >> 5;
    const int map = wid >> 2, wq = wid & 3;
    bf16* Pb = P + (size_t)b * SEQ * PP;
    const int rowpos = 128 * qb + 32 * wq + r32;
    bf16x8 qf[8];
    { const bf16* qp = Pb + (size_t)rowpos * PP + (2 * h + map) * 128 + 8 * hq;
#pragma unroll
      for (int s = 0; s < 8; ++s) qf[s] = *(const GAS bf16x8*)(qp + 16 * s); }
    const int NT = 2 * qb + 2;
    const unsigned rb0 = rr_base(lane, 0) + map * 16384, rb1 = rr_base(lane, 1) + map * 16384, tp0 = trp_base(lane, 0) + 32768, tp1 = trp_base(lane, 1) + 32768;
    f32x16 o[8];
#pragma unroll
    for (int c = 0; c < 8; ++c) o[c] = f32x16{};
    float m_run = -1e30f, l_run = 0.f;
    const unsigned lds0 = (unsigned)(unsigned long)lds;
    attn_dma(lds0, Pb, h, 0, 0, wid, lane);
    asm volatile("s_waitcnt vmcnt(0)" ::: "memory"); __syncthreads();
    for (int t = 0; t < NT; ++t) {
        const int st = t & 1;
        if (t + 1 < NT) attn_dma(lds0, Pb, h, t + 1, st ^ 1, wid, lane);
        const LAS unsigned char* SB = lds + st * AT_STAGE;
        f32x16 p0 = f32x16{}, p1 = f32x16{};
#pragma unroll
        for (int ks = 0; ks < 8; ++ks) { const unsigned ko = ((ks & 1) ? rb1 : rb0) + 512 * (ks >> 1);
            const bf16x8 a0 = *(const LAS bf16x8*)(SB + ko), a1 = *(const LAS bf16x8*)(SB + ko + 8192);
            p0 = __builtin_amdgcn_mfma_f32_32x32x16_bf16(a0, qf[ks], p0, 0, 0, 0); p1 = __builtin_amdgcn_mfma_f32_32x32x16_bf16(a1, qf[ks], p1, 0, 0, 0); }
        if (t >= NT - 2) { const int kb = 64 * t; const float NEG = -__builtin_inff();
#pragma unroll
            for (int r = 0; r < 16; ++r) { const int key = kb + crow(r, hq); if (key > rowpos) p0[r] = NEG; if (key + 32 > rowpos) p1[r] = NEG; } }
        float pmax = p0[0];
#pragma unroll
        for (int r = 1; r < 16; ++r) pmax = fmaxf(pmax, p0[r]);
#pragma unroll
        for (int r = 0; r < 16; ++r) pmax = fmaxf(pmax, p1[r]);
        pmax = swap32_max(pmax);
        if (!__all((pmax - m_run) * LOG2E <= 8.f)) {
            const float mn = fmaxf(m_run, pmax), alpha = __builtin_amdgcn_exp2f((m_run - mn) * LOG2E); m_run = mn; l_run *= alpha;
#pragma unroll
            for (int c = 0; c < 8; ++c)
#pragma unroll
                for (int r = 0; r < 16; ++r) o[c][r] *= alpha; }
        { const float ml = -m_run * LOG2E; float ps = 0.f;
#pragma unroll
          for (int r = 0; r < 16; ++r) { p0[r] = __builtin_amdgcn_exp2f(fmaf(p0[r], LOG2E, ml)); ps += p0[r]; }
#pragma unroll
          for (int r = 0; r < 16; ++r) { p1[r] = __builtin_amdgcn_exp2f(fmaf(p1[r], LOG2E, ml)); ps += p1[r]; }
          l_run += ps; }
        bf16x8 pb[4]; pb[0] = pack8f(p0, 0); pb[1] = pack8f(p0, 8); pb[2] = pack8f(p1, 0); pb[3] = pack8f(p1, 8);
#define AT_VO(i) ((((i) >> 2) >> 2) * 16384 + 512 * (((i) >> 2) & 3) + 4096 * ((i) & 3))
        { bf16x8 va0 = cat8(vtr(SB + tp0 + AT_VO(0)), vtr(SB + tp1 + AT_VO(0))), va1 = cat8(vtr(SB + tp0 + AT_VO(1)), vtr(SB + tp1 + AT_VO(1)));
#pragma unroll
          for (int i = 0; i < 32; ++i) {
              bf16x8 vn = va1; if (i + 2 < 32) vn = cat8(vtr(SB + tp0 + AT_VO(i + 2)), vtr(SB + tp1 + AT_VO(i + 2)));
              o[i >> 2] = __builtin_amdgcn_mfma_f32_32x32x16_bf16(va0, pb[i & 3], o[i >> 2], 0, 0, 0);
              va0 = va1; va1 = vn; } }
#undef AT_VO
        asm volatile("s_waitcnt vmcnt(0)" ::: "memory"); __syncthreads();
    }
    { const float inv = 1.f / swap32_sum(l_run); const float f = (map == 1) ? inv * lamv : inv;
      LAS float* XB = (LAS float*)lds + (size_t)wq * 8 * 16 * 64 + lane;
      if (map == 1) {
#pragma unroll
          for (int c = 0; c < 8; ++c)
#pragma unroll
              for (int r = 0; r < 16; ++r) XB[(c * 16 + r) * 64] = o[c][r] * f; }
      __syncthreads();
      if (map == 0) { float ss = 0.f;
#pragma unroll
          for (int c = 0; c < 8; ++c)
#pragma unroll
              for (int r = 0; r < 16; ++r) { const float d = o[c][r] * f - XB[(c * 16 + r) * 64]; o[c][r] = d; ss += d * d; }
          ss = swap32_sum(ss); const float rs = omli / sqrtf(ss * (1.f / 256.f) + NORM_EPS);
          bf16* op = Pb + (size_t)rowpos * PP + 256 * h + 4 * hq;
#pragma unroll
          for (int c = 0; c < 8; ++c)
#pragma unroll
              for (int g4 = 0; g4 < 4; ++g4) { const f32x4 gg = *(const GAS f32x4*)(subg + 32 * c + 8 * g4 + 4 * hq);
                  u32x2 w; w.x = cvt_pk(o[c][4 * g4] * rs * gg[0], o[c][4 * g4 + 1] * rs * gg[1]); w.y = cvt_pk(o[c][4 * g4 + 2] * rs * gg[2], o[c][4 * g4 + 3] * rs * gg[3]);
                  if (st) *(GAS u32x2*)(op + 32 * c + 8 * g4) = w; } }
      __syncthreads(); }
}


#define IN(k) (lo <= (k) && (k) < hi)
#define SEAM(k) do { if (IN(k) && IN((k) + 1)) xcd_barrier(bar); } while (0)
template <int j> __device__ __forceinline__ void layer_pair(Frame& F, const Args& args, const int lo, const int hi, const XcdBarrier& bar) {
    unsigned char* ws; constexpr int LDZ = PP / 2;
        const int pb = 1 + 9 * j;
        { unsigned char* wsj = args.ws; asm volatile("" : "+s"(wsj)); ws = wsj; }
        int Gj = gridDim.x, bxj = blockIdx.x, vcuj = F.vcu; asm volatile("" : "+s"(Gj), "+s"(bxj), "+s"(vcuj)); F.G = Gj; F.vcu = vcuj;
        bf16* P = (bf16*)(ws + WS_P); bf16* X16 = (bf16*)(ws + WS_X16); bf16* WIN = (bf16*)(ws + WS_WIN);
        const float* COS = (const float*)(ws + WS_ROPE); const float* SIN = COS + SEQ * 64;
        float* Z = (float*)(ws + WS_P) + 1024;
        if (IN(pb + 0)) {
            pg8::Gemm g{X16, WIN, MTOK, 6144, 1024, 1024}; pg8::StaticOrder S; S.init(MTOK, 6144, F.G, bxj);
            pg8::EpiIn<false> E{P, COS, SIN};
#ifndef NO_E1
            pg8::gemm_phase<pg8::EpiIn<false>, pg8::StaticOrder, true, true>(F.lds, g, S, E);
#if PROBE_MASK & 1
            pg8::gemm_phase<pg8::EpiIn<false>, pg8::StaticOrder, true, true>(F.lds, g, S, E);
#endif
#endif
        } SEAM(pb + 0);
        if (IN(pb + 1)) {
#if PROBE_MASK & (2 | 32 | 64)
            { const bool dry = hi > 1000;
              for (int u = F.vcu; u < 256; u += F.G) {
                if ((PROBE_MASK & 64) && u < 128) continue;
                if ((PROBE_MASK & 32) && u >= 128) continue;
                if (u < 128) retention_unit(F.lds, P, args.in[9] + j * 1024, args.in[10] + j * 1024, u >> 3, u & 7, dry);
                else { const int v = u - 128; lru_unit(F.lds, P, (const bf16*)(ws + WS_WG) + (size_t)j * 2 * 8 * 16384, args.in[2] + j * 4096, args.in[3] + j * 1024,
                                                        args.in[5] + j * 1024, args.in[7] + j * 1024, args.in[8] + j * 1024, v >> 3, v & 7, dry); } }
              __syncthreads(); }
#endif
            for (int u = F.vcu; u < 256; u += F.G) {
#ifndef NO_RET
                if (u < 128) retention_unit(F.lds, P, args.in[9] + j * 1024, args.in[10] + j * 1024, u >> 3, u & 7);
#endif
#ifndef NO_LRU
                if (u >= 128) { const int v = u - 128; lru_unit(F.lds, P, (const bf16*)(ws + WS_WG) + (size_t)j * 2 * 8 * 16384, args.in[2] + j * 4096, args.in[3] + j * 1024,
                                                        args.in[5] + j * 1024, args.in[7] + j * 1024, args.in[8] + j * 1024, v >> 3, v & 7); }
#endif
            }
        } SEAM(pb + 1);
        if (IN(pb + 2)) {
            pg8::Gemm g{P, (const bf16*)(ws + WS_WOUT) + (size_t)(2 * j) * 2048 * 1024, MTOK, 1024, 2048, PP}; pg8::StaticOrder S; S.init(MTOK, 1024, F.G, bxj);
            pg8::EpiOut E{j == 0 ? args.in[0] : args.out, Z, LDZ};
#ifndef NO_E3
            pg8::gemm_phase<pg8::EpiOut, pg8::StaticOrder, true, true>(F.lds, g, S, E);
#if PROBE_MASK & 8
            pg8::gemm_phase<pg8::EpiOut, pg8::StaticOrder, true, true>(F.lds, g, S, E);
#endif
#endif
        } SEAM(pb + 2);
        if (IN(pb + 3)) {
#ifndef NO_LN
            ln_phase(F, Z, LDZ, args.in[12] + j * 1024, args.in[13] + j * 1024, args.out, X16);
#if PROBE_MASK & 16
            ln_phase(F, Z, LDZ, args.in[12] + j * 1024, args.in[13] + j * 1024, args.out, X16);
#endif
            conv_win<true>(F, args.in[14] + (size_t)j * 1024 * 8192, WIN);
#endif
        } SEAM(pb + 3);
        if (IN(pb + 4)) {
            pg8::Gemm g{X16, WIN, MTOK, 6144, 1024, 1024}; pg8::StaticOrder S; S.init(MTOK, 6144, F.G, bxj);
            pg8::EpiIn<true> E{P, COS, SIN};
#ifndef NO_O1
            pg8::gemm_phase<pg8::EpiIn<true>, pg8::StaticOrder, true, true>(F.lds, g, S, E);
#if PROBE_MASK & 1
            pg8::gemm_phase<pg8::EpiIn<true>, pg8::StaticOrder, true, true>(F.lds, g, S, E);
#endif
#endif
        } SEAM(pb + 4);
        if (IN(pb + 5)) {
            const float lamv = ((const float*)(ws + WS_PAR))[j]; const float omli = 1.f - ((j == 0) ? 0.35550906759096927f : 0.55605820415654060f);
#if PROBE_MASK & 4
            { const bool dry = hi > 1000;
              for (int it = F.vcu; it < 1024; it += F.G) { const int bh = it >> 3, x = it & 7;
                attn_qblock(F.lds, P, args.in[19] + j * 256, lamv, omli, bh >> 3, bh & 7, 15 - x, dry);
                attn_qblock(F.lds, P, args.in[19] + j * 256, lamv, omli, bh >> 3, bh & 7, x, dry); } }
#endif
            for (int it = F.vcu; it < 1024; it += F.G) { const int bh = it >> 3, x = it & 7;
#ifndef NO_ATT
                attn_qblock(F.lds, P, args.in[19] + j * 256, lamv, omli, bh >> 3, bh & 7, 15 - x);
                attn_qblock(F.lds, P, args.in[19] + j * 256, lamv, omli, bh >> 3, bh & 7, x);
#endif
            }
        } SEAM(pb + 5);
        if (IN(pb + 6)) {
            pg8::Gemm g{X16, WIN + (size_t)6144 * 1024, MTOK, 2048, 1024, 1024}; pg8::StaticOrder S; S.init(MTOK, 2048, F.G, bxj);
            pg8::EpiGate E{P};
#ifndef NO_O3
            pg8::gemm_phase<pg8::EpiGate, pg8::StaticOrder, true, true>(F.lds, g, S, E);
#endif
        } SEAM(pb + 6);
        if (IN(pb + 7)) {
            pg8::Gemm g{P, (const bf16*)(ws + WS_WOUT) + (size_t)(2 * j + 1) * 2048 * 1024, MTOK, 1024, 2048, PP}; pg8::StaticOrder S; S.init(MTOK, 1024, F.G, bxj);
            pg8::EpiOut E{args.out, Z, LDZ};
#ifndef NO_O4
            pg8::gemm_phase<pg8::EpiOut, pg8::StaticOrder, true, true>(F.lds, g, S, E);
#if PROBE_MASK & 8
            pg8::gemm_phase<pg8::EpiOut, pg8::StaticOrder, true, true>(F.lds, g, S, E);
#endif
#endif
        } SEAM(pb + 7);
        if (IN(pb + 8)) {
#ifndef NO_LN
            ln_phase(F, Z, LDZ, args.in[21] + j * 1024, args.in[22] + j * 1024, args.out, X16);
#if PROBE_MASK & 16
            ln_phase(F, Z, LDZ, args.in[21] + j * 1024, args.in[22] + j * 1024, args.out, X16);
#endif
            if (j == 0) conv_win<false>(F, args.in[1] + (size_t)1024 * 6144, WIN);
#endif
        } SEAM(pb + 8);
}
#undef IN
#undef SEAM
constexpr int N_PHASES = 19;
__global__ void __launch_bounds__(NWAVES * 64, 2) fwd_kernel(Args args) {
    extern __shared__ __attribute__((aligned(16))) unsigned char lds_raw[];
    Frame F;
    F.lds = (LAS unsigned char*)lds_raw;
    F.tid = threadIdx.x; F.lane = F.tid & 63; F.wave = __builtin_amdgcn_readfirstlane(F.tid >> 6);
    F.G = gridDim.x; { const int bx = blockIdx.x; F.vcu = (F.G % 8 == 0) ? (bx % 8) * (F.G / 8) + bx / 8 : bx; }
    unsigned char* ws = args.ws;
    gu32* ctl = (gu32*)(ws + WS_CTL);
    volatile LAS unsigned* MISC = (volatile LAS unsigned*)(F.lds + MISC_OFF);
    if (F.tid < 64) MISC[F.tid] = 0u;
    __syncthreads();
    const int lo = args.ph_lo, hi = args.ph_hi;
    XcdBarrier bar; bar.bar = (unsigned*)(ctl + CW_BAR); bar.x = 0; bar.st = nullptr;
    if (hi - lo > 1) bar = xcd_barrier_post((unsigned*)(ctl + CW_BAR), MISC + 8);
#define IN(k) (lo <= (k) && (k) < hi)
#define SEAM(k) do { if (IN(k) && IN((k) + 1)) xcd_barrier(bar); } while (0)
    constexpr int LDZ = PP / 2;

#ifndef NO_P0
    if (IN(0)) { p0_prologue(F, args); } SEAM(0);
#else
    SEAM(0);
#endif

    layer_pair<0>(F, args, lo, hi, bar);
    layer_pair<1>(F, args, lo, hi, bar);
#undef IN
#undef SEAM
}

extern "C" void kernel_launch(void* const* d_in, const int* in_sizes, int n_in, void* d_out, int out_size, void* d_ws, size_t ws_size, hipStream_t stream) {
    static int grid = 0;
    if (grid == 0) {
        if (n_in != 23 || in_sizes[0] != MTOK * DM || out_size != MTOK * DM || ws_size < WS_END) {
            fprintf(stderr, "kernel_launch: unexpected shapes (n_in %d, in0 %d, out %d, ws %zu < %zu); nothing launched\n", n_in, n_in > 0 ? in_sizes[0] : -1, out_size, ws_size, (size_t)WS_END); grid = -1; return; }
        int dev = 0, cus = 0, per_cu = 0;
        if (hipGetDevice(&dev) != hipSuccess || hipDeviceGetAttribute(&cus, hipDeviceAttributeMultiprocessorCount, dev) != hipSuccess) { grid = -1; return; }
        if (hipFuncSetAttribute((const void*)fwd_kernel, hipFuncAttributeMaxDynamicSharedMemorySize, LDS_BYTES) != hipSuccess) { fprintf(stderr, "kernel_launch: hipFuncSetAttribute failed\n"); grid = -1; return; }
        if (hipOccupancyMaxActiveBlocksPerMultiprocessor(&per_cu, (const void*)fwd_kernel, NWAVES * 64, LDS_BYTES) != hipSuccess || per_cu < 1)
            fprintf(stderr, "kernel_launch: note: occupancy query reports %d workgroups per CU\n", per_cu);
        (void)hipGetLastError();
        grid = cus;
    }
    if (grid < 0) return;
    (void)hipMemsetAsync((char*)d_ws + WS_CTL, 0, CTL_ZERO_BYTES, stream);
    Args a{};
    for (int i = 0; i < 23; ++i) a.in[i] = (const float*)d_in[i];
    a.out = (float*)d_out; a.ws = (unsigned char*)d_ws;
#if MK_SPLIT
    for (int p = 0; p < N_PHASES; ++p) { a.ph_lo = p; a.ph_hi = p + 1; hipLaunchKernelGGL(fwd_kernel, dim3(grid), dim3(NWAVES * 64), LDS_BYTES, stream, a); }
#else
    a.ph_lo = 0; a.ph_hi = N_PHASES;
    hipLaunchKernelGGL(fwd_kernel, dim3(grid), dim3(NWAVES * 64), LDS_BYTES, stream, a);
#endif
    const hipError_t le = hipPeekAtLastError();
    if (le != hipSuccess) fprintf(stderr, "kernel_launch: launch failed: %s\n", hipGetErrorName(le));
}
```

```cpp
#include <hip/hip_runtime.h>
#include <cstdio>
#include <cstdint>

#ifndef MK_SPLIT
#define MK_SPLIT 0
#endif

#ifndef PROBE_MASK
#define PROBE_MASK 0
#endif
#define GAS __attribute__((address_space(1)))
#define LAS __attribute__((address_space(3)))
typedef unsigned short bf16;
typedef short bf16x8 __attribute__((ext_vector_type(8)));
typedef short s16x4 __attribute__((ext_vector_type(4)));
typedef float f32x4 __attribute__((ext_vector_type(4)));
typedef float f32x16 __attribute__((ext_vector_type(16)));
typedef unsigned u32x4 __attribute__((ext_vector_type(4)));
typedef unsigned u32x2 __attribute__((ext_vector_type(2)));

constexpr int BATCH = 16, SEQ = 2048, DM = 1024, MTOK = BATCH * SEQ;
constexpr int PP = 6144;
constexpr float DN_ALPHA = 1.6817928305074290f;
constexpr float NORM_EPS = 1e-5f;
constexpr float QK_SCALE = 0.08838834764831845f;
constexpr float LOG2E = 1.4426950408889634f;

constexpr size_t MiB = 1u << 20;
constexpr size_t WS_CTL = 0, CTL_ZERO_BYTES = 1 * MiB;
constexpr size_t WS_ROPE = 1 * MiB;
constexpr size_t WS_PAR = 2 * MiB;
constexpr size_t WS_WG = 3 * MiB;
constexpr size_t WS_WOUT = 4 * MiB;
constexpr size_t WS_WIN = 20 * MiB;
constexpr size_t WS_X16 = 36 * MiB;
constexpr size_t WS_P = 100 * MiB;
constexpr size_t WS_END = 484 * MiB;
constexpr int CW_BAR = 4096;

constexpr int LDS_BYTES = 147456;
constexpr int LDS_X = 131072;
constexpr int MISC_OFF = LDS_BYTES - 256;

typedef float f32x2_t __attribute__((ext_vector_type(2))); typedef __bf16 bf16x2_t __attribute__((ext_vector_type(2)));
__device__ __forceinline__ unsigned cvt_pk(float lo, float hi) { f32x2_t v = {lo, hi}; bf16x2_t b = __builtin_convertvector(v, bf16x2_t); return __builtin_bit_cast(unsigned, b); }
__device__ __forceinline__ float bf_lo(unsigned w) { return __uint_as_float(w << 16); }
__device__ __forceinline__ float bf_hi(unsigned w) { return __uint_as_float(w & 0xffff0000u); }
__device__ __forceinline__ float silu_f(float x) { return x * __builtin_amdgcn_rcpf(1.0f + __builtin_amdgcn_exp2f(-LOG2E * x)); }
__device__ __forceinline__ float sigmoid_f(float x) { return __builtin_amdgcn_rcpf(1.0f + __builtin_amdgcn_exp2f(-LOG2E * x)); }
__device__ __forceinline__ int crow(int r, int hi) { return (r & 3) + 8 * (r >> 2) + 4 * hi; }
#define LDS_WAIT() asm volatile("s_waitcnt lgkmcnt(0)" ::: "memory")
#define VM_WAIT() asm volatile("s_waitcnt vmcnt(0)" ::: "memory")

__device__ __forceinline__ unsigned off_a(unsigned row, unsigned ch) { return 2048u * (row >> 3) + 512u * (ch >> 2) + 64u * (row & 7) + 16u * ((ch & 3) ^ ((row >> 2) & 3)); }
__device__ __forceinline__ unsigned rr_base(int lane, int par) { const unsigned r = lane & 31, h = lane >> 5; return 2048u * (r >> 3) + 64u * (r & 7) + 16u * ((2u * par + h) ^ ((r >> 2) & 3)); }
__device__ __forceinline__ unsigned trn_base(int lane, int t) { const unsigned h = lane >> 5, blk = (lane >> 4) & 1, q = (lane & 15) >> 2, p = lane & 3;
    return 2048u * h + 64u * (4u * t + q) + 16u * ((2u * blk + (p >> 1)) ^ ((2u * h + t) & 3)) + 8u * (p & 1); }
__device__ __forceinline__ unsigned trp_base(int lane, int t) { const unsigned h = lane >> 5, blk = (lane >> 4) & 1, q = (lane & 15) >> 2, p = lane & 3;
    return 2048u * t + 64u * (4u * h + q) + 16u * ((2u * blk + (p >> 1)) ^ ((2u * t + h) & 3)) + 8u * (p & 1); }
typedef short v4i16_t __attribute__((ext_vector_type(4)));
__device__ __forceinline__ s16x4 vtr(const LAS unsigned char* p) { return __builtin_bit_cast(s16x4, __builtin_amdgcn_ds_read_tr16_b64_v4i16((LAS v4i16_t*)p)); }
__device__ __forceinline__ bf16x8 cat8(s16x4 a, s16x4 b) { return (bf16x8){a[0], a[1], a[2], a[3], b[0], b[1], b[2], b[3]}; }
__device__ __forceinline__ bf16x8 pack8f(const f32x16& x, int o) {
    u32x4 w = {cvt_pk(x[o + 0], x[o + 1]), cvt_pk(x[o + 2], x[o + 3]), cvt_pk(x[o + 4], x[o + 5]), cvt_pk(x[o + 6], x[o + 7])};
    return __builtin_bit_cast(bf16x8, w); }
__device__ __forceinline__ float swap32_max(float v) { auto rr = __builtin_amdgcn_permlane32_swap(__float_as_uint(v), __float_as_uint(v), false, false); return fmaxf(__uint_as_float(rr[0]), __uint_as_float(rr[1])); }
__device__ __forceinline__ float swap32_sum(float v) { auto rr = __builtin_amdgcn_permlane32_swap(__float_as_uint(v), __float_as_uint(v), false, false); return __uint_as_float(rr[0]) + __uint_as_float(rr[1]); }

namespace pg8 {
#define PG8_LAS __attribute__((address_space(3)))
typedef unsigned short bf16_t;
typedef short bf16x8 __attribute__((ext_vector_type(8)));
typedef float f32x4 __attribute__((ext_vector_type(4)));
typedef unsigned u32x4 __attribute__((ext_vector_type(4)));
constexpr int BM = 256, BK = 64, HALF = 128, HTB = HALF * BK * 2  , STAGE_BYTES = 8 * HTB, NXCD = 8, WGM = 8;

__host__ __device__ __forceinline__ int lds_byte(int r, int c) { const int st = (r >> 4) * 2 + (c >> 5), rr = r & 15, cc = c & 31, ob = rr * 64 + cc * 2; return st * 1024 + (ob ^ (((ob >> 9) & 1) << 5)); }
__host__ __device__ __forceinline__ void stage_rc(int b, int& R, int& C) { const int st = b / 1024, sb = b % 1024, swz = sb ^ (((sb >> 9) & 1) << 5); R = (st >> 1) * 16 + swz / 64; C = (st & 1) * 32 + (swz % 64) / 2; }
__host__ __device__ __forceinline__ int perm32(int rho) { const int n = rho >> 4, i = rho & 15; return 8 * (i >> 2) + 4 * n + (i & 3); }

struct Unit { int pm, pn; };
struct Gemm { const bf16_t* A; const bf16_t* Bt; int M, N, K, lda; };

struct StaticOrder {
    int nM, nN, nwg, G, c;
    __host__ __device__ void init(int M, int N, int G_, int c_) { nM = M / BM; nN = N / BM; nwg = nM * nN; G = G_; c = c_; }
    __host__ __device__ bool next(int i, Unit& u) const {
        const long L = (long)i * G + c; if (L >= nwg) return false;
        int wgid = (int)L; { const int q = nwg / NXCD, r = nwg % NXCD, xcd = wgid % NXCD, off = wgid / NXCD; wgid = (xcd < r ? xcd * (q + 1) : r * (q + 1) + (xcd - r) * q) + off; }
        const int nig = WGM * nN, gid = wgid / nig, fm = gid * WGM, gsz = (nM - fm) < WGM ? (nM - fm) : WGM;
        u.pm = fm + ((wgid % nig) % gsz); u.pn = (wgid % nig) / gsz; return true;
    }
    __device__ __forceinline__ void a_ready(const Unit&) const {}
    __device__ __forceinline__ void done(const Unit&) const {}
};

__device__ __forceinline__ unsigned cvt_pk_bf16(float lo, float hi) { return cvt_pk(lo, hi); }
typedef float f32x2 __attribute__((ext_vector_type(2)));
struct PanelStats {
    unsigned* xbuf;
    unsigned* cnt;
    unsigned* tmo;
    int ntn; float eps;
    unsigned code;
    __device__ __forceinline__ bool run(const f32x4 (&v)[2][2][4][2], const Unit& u, int wr, int wc, int fr, int fq, PG8_LAS unsigned char* lds, int wid, int lane) const {
        typedef float f32x2v __attribute__((ext_vector_type(2)));
        PG8_LAS f32x2v* P = (PG8_LAS f32x2v*)lds;
        PG8_LAS f32x2v* S = (PG8_LAS f32x2v*)(lds + 8192);
        PG8_LAS unsigned* flag = (PG8_LAS unsigned*)(lds + 8192 + 2048);
#pragma unroll
        for (int ai = 0; ai < 2; ++ai)
#pragma unroll
            for (int m = 0; m < 4; ++m) {
                float s = 0.f;
#pragma unroll
                for (int bj = 0; bj < 2; ++bj)
#pragma unroll
                    for (int n = 0; n < 2; ++n) { const f32x4 x = v[ai][bj][m][n]; s += (x[0] + x[1]) + (x[2] + x[3]); }
                s += __shfl_xor(s, 16); s += __shfl_xor(s, 32);
                const float mw = s * (1.0f / 64.0f); float q = 0.f;
#pragma unroll
                for (int bj = 0; bj < 2; ++bj)
#pragma unroll
                    for (int n = 0; n < 2; ++n) { const f32x4 d = v[ai][bj][m][n] - mw; q += (d[0] * d[0] + d[1] * d[1]) + (d[2] * d[2] + d[3] * d[3]); }
                q += __shfl_xor(q, 16); q += __shfl_xor(q, 32);
                if (fq == 0) P[(ai * HALF + wr * 64 + m * 16 + fr) * 4 + wc] = (f32x2v){mw, q};
            }
        asm volatile("s_waitcnt lgkmcnt(0)" ::: "memory"); __builtin_amdgcn_s_barrier(); asm volatile("" ::: "memory");
#if defined(BROKEN_EXCHANGE_NO_WAIT)
#warning BROKEN CONTROL BUILD: the row-statistics exchange does not wait; results are wrong by design
        if (blockIdx.x >= 64) { const long long t0_ = clock64(); while (clock64() - t0_ < 60000) __builtin_amdgcn_s_sleep(8); }
#endif
        const int row = wid * 32 + (lane & 31);
        if (lane < 32) {
            const f32x2v a = P[row * 4 + 0], b = P[row * 4 + 1], c = P[row * 4 + 2], d = P[row * 4 + 3];
            const float mt = (a.x + b.x + c.x + d.x) * 0.25f;
            const float da = a.x - mt, db = b.x - mt, dc = c.x - mt, dd = d.x - mt;
            const float m2 = (a.y + b.y) + (c.y + d.y) + 64.0f * ((da * da + db * db) + (dc * dc + dd * dd));
            unsigned long long* slot = (unsigned long long*)xbuf + ((size_t)(u.pm * BM + row) * 4 + u.pn);
            __hip_atomic_store(slot, ((unsigned long long)__float_as_uint(m2) << 32) | __float_as_uint(mt), __ATOMIC_RELAXED, __HIP_MEMORY_SCOPE_AGENT);
        }
        asm volatile("s_waitcnt vmcnt(0)" ::: "memory");
        if (lane == 0) __hip_atomic_fetch_add(cnt + 64 * u.pm, 1u, __ATOMIC_RELAXED, __HIP_MEMORY_SCOPE_AGENT);
        if (wid == 0) {
            bool dead = false; const unsigned long long t0 = __builtin_amdgcn_s_memrealtime(); const unsigned want = 8u * (unsigned)ntn;
            for (;;) {
#if defined(BROKEN_EXCHANGE_NO_WAIT)
                break;
#endif
                if ((unsigned)__builtin_amdgcn_readfirstlane(__hip_atomic_load(cnt + 64 * u.pm, __ATOMIC_RELAXED, __HIP_MEMORY_SCOPE_AGENT)) >= want) break;
                if (__builtin_amdgcn_s_memrealtime() - t0 > 2000000ull) {
                    if (lane == 0) { unsigned expect = 0u; __hip_atomic_compare_exchange_strong(tmo + 1, &expect, code | (unsigned)(u.pm & 0xff), __ATOMIC_RELAXED, __ATOMIC_RELAXED, __HIP_MEMORY_SCOPE_AGENT);
                                     __hip_atomic_store(tmo, 1u, __ATOMIC_RELAXED, __HIP_MEMORY_SCOPE_AGENT); }
                    dead = true; break; }
                __builtin_amdgcn_s_sleep(2);
            }
            __builtin_amdgcn_fence(__ATOMIC_ACQUIRE, "agent");
            if (lane == 0) flag[0] = dead ? 1u : 0u;
        }
        asm volatile("s_waitcnt vmcnt(0) lgkmcnt(0)" ::: "memory"); __builtin_amdgcn_s_barrier(); asm volatile("" ::: "memory");
        const bool bad = flag[0] != 0u;
        if (lane < 32) {
            const unsigned long long* slot = (const unsigned long long*)xbuf + (size_t)(u.pm * BM + row) * 4; float mt[4], m2[4]; float ms = 0.f;
#pragma unroll
            for (int t = 0; t < 4; ++t) { if (t < ntn) { const unsigned long long w = __hip_atomic_load(slot + t, __ATOMIC_RELAXED, __HIP_MEMORY_SCOPE_AGENT); mt[t] = __uint_as_float((unsigned)w); m2[t] = __uint_as_float((unsigned)(w >> 32)); } else { mt[t] = 0.f; m2[t] = 0.f; } ms += mt[t]; }
            const float mean = ms / (float)ntn; float q = 0.f;
#pragma unroll
            for (int t = 0; t < 4; ++t) if (t < ntn) { const float dm = mt[t] - mean; q += m2[t] + 256.0f * dm * dm; }
            S[row] = (f32x2v){mean, 1.0f / sqrtf(q / (256.0f * (float)ntn) + eps)};
        }
        asm volatile("s_waitcnt lgkmcnt(0)" ::: "memory"); __builtin_amdgcn_s_barrier(); asm volatile("" ::: "memory");
        return bad;
    }
};
template <bool ODD> struct EpiIn {
    static constexpr bool PERM = true, AFTER_DRAIN = false;
    bf16_t* P; const float* COS; const float* SIN;
    __device__ __forceinline__ void operator()(const f32x4 (&acc)[2][2][4][2], const Unit& u, int wr, int wc, int fr, int fq) const {
        const int row0 = u.pm * BM + wr * 64 + fr;
        int kind; float scale = 1.f;
        if (!ODD) { const int reg = u.pn >> 2; kind = reg < 2 ? 1 : (reg < 4 ? 2 : 0); if (reg == 3) scale = QK_SCALE; }
        else      { const int reg = u.pn >> 3; kind = reg < 2 ? 2 : 0; if (reg == 0) scale = QK_SCALE; }
        if (kind == 2) {
            const int hd = (wc >> 1) * 128, dlow = 32 * (wc & 1) + 8 * fq;
            bf16_t* pb = P + (size_t)u.pn * BM + hd + dlow;
#pragma unroll
            for (int ai = 0; ai < 2; ++ai)
#pragma unroll
                for (int m = 0; m < 4; ++m) { const int row = row0 + ai * HALF + m * 16, pos = row & (SEQ - 1);
                    const float* cp = COS + pos * 64 + dlow; const float* sp = SIN + pos * 64 + dlow;
                    const f32x4 c0 = *(const GAS f32x4*)cp, c1 = *(const GAS f32x4*)(cp + 4), s0 = *(const GAS f32x4*)sp, s1 = *(const GAS f32x4*)(sp + 4);
                    const f32x4 x10 = acc[ai][0][m][0], x11 = acc[ai][0][m][1], x20 = acc[ai][1][m][0], x21 = acc[ai][1][m][1];
                    const f32x4 a0 = (x10 * c0 - x20 * s0) * scale, a1 = (x11 * c1 - x21 * s1) * scale, b0 = (x20 * c0 + x10 * s0) * scale, b1 = (x21 * c1 + x11 * s1) * scale;
                    u32x4 w1, w2; w1.x = cvt_pk_bf16(a0[0], a0[1]); w1.y = cvt_pk_bf16(a0[2], a0[3]); w1.z = cvt_pk_bf16(a1[0], a1[1]); w1.w = cvt_pk_bf16(a1[2], a1[3]);
                    w2.x = cvt_pk_bf16(b0[0], b0[1]); w2.y = cvt_pk_bf16(b0[2], b0[3]); w2.z = cvt_pk_bf16(b1[0], b1[1]); w2.w = cvt_pk_bf16(b1[2], b1[3]);
                    bf16_t* rp = pb + (size_t)row * PP; *(GAS u32x4*)rp = w1; *(GAS u32x4*)(rp + 64) = w2;
                    if (m == 3) asm volatile("" ::: "memory"); }
        } else {
            bf16_t* pb = P + (size_t)u.pn * BM + wc * 32 + 8 * fq;
#pragma unroll
            for (int ai = 0; ai < 2; ++ai)
#pragma unroll
                for (int m = 0; m < 4; ++m) { bf16_t* rp = pb + (size_t)(row0 + ai * HALF + m * 16) * PP;
#pragma unroll
                    for (int bj = 0; bj < 2; ++bj) { f32x4 v0 = acc[ai][bj][m][0], v1 = acc[ai][bj][m][1];
                        if (kind == 1) { v0 = (f32x4){silu_f(v0[0]), silu_f(v0[1]), silu_f(v0[2]), silu_f(v0[3])}; v1 = (f32x4){silu_f(v1[0]), silu_f(v1[1]), silu_f(v1[2]), silu_f(v1[3])}; }
                        u32x4 w; w.x = cvt_pk_bf16(v0[0], v0[1]); w.y = cvt_pk_bf16(v0[2], v0[3]); w.z = cvt_pk_bf16(v1[0], v1[1]); w.w = cvt_pk_bf16(v1[2], v1[3]);
                        *(GAS u32x4*)(rp + bj * HALF) = w; } }
        }
    }
};
struct EpiGate {
    static constexpr bool PERM = true, AFTER_DRAIN = false;
    bf16_t* P;
    __device__ __forceinline__ void operator()(const f32x4 (&acc)[2][2][4][2], const Unit& u, int wr, int wc, int fr, int fq) const {
        const int row0 = u.pm * BM + wr * 64 + fr;
        bf16_t* pb = P + (size_t)u.pn * BM + wc * 32 + 8 * fq;
#pragma unroll
        for (int ai = 0; ai < 2; ++ai)
#pragma unroll
            for (int m = 0; m < 4; ++m) { bf16_t* rp = pb + (size_t)(row0 + ai * HALF + m * 16) * PP;
#pragma unroll
                for (int bj = 0; bj < 2; ++bj) { const f32x4 v0 = acc[ai][bj][m][0], v1 = acc[ai][bj][m][1]; const u32x4 a = *(const GAS u32x4*)(rp + bj * HALF);
                    u32x4 w; w.x = cvt_pk_bf16(bf_lo(a.x) * silu_f(v0[0]), bf_hi(a.x) * silu_f(v0[1])); w.y = cvt_pk_bf16(bf_lo(a.y) * silu_f(v0[2]), bf_hi(a.y) * silu_f(v0[3]));
                    w.z = cvt_pk_bf16(bf_lo(a.z) * silu_f(v1[0]), bf_hi(a.z) * silu_f(v1[1])); w.w = cvt_pk_bf16(bf_lo(a.w) * silu_f(v1[2]), bf_hi(a.w) * silu_f(v1[3]));
                    *(GAS u32x4*)(rp + bj * HALF) = w; }
                if (m == 3) asm volatile("" ::: "memory"); }
    }
};
struct EpiOut {
    static constexpr bool PERM = false, AFTER_DRAIN = false;
    const float* xres; float* Z; int ldz;
    __device__ __forceinline__ void operator()(const f32x4 (&acc)[2][2][4][2], const Unit& u, int wr, int wc, int fr, int fq) const {
        const int row0 = u.pm * BM + wr * 64 + fr, col0 = u.pn * BM + wc * 32 + 4 * fq;
#pragma unroll
        for (int ai = 0; ai < 2; ++ai)
#pragma unroll
            for (int m = 0; m < 4; ++m) { const int row = row0 + ai * HALF + m * 16; const float* xr = xres + (size_t)row * DM + col0; float* zr = Z + (size_t)row * ldz + col0;
#pragma unroll
                for (int bj = 0; bj < 2; ++bj)
#pragma unroll
                    for (int n = 0; n < 2; ++n) { const f32x4 x = *(const GAS f32x4*)(xr + bj * HALF + n * 16); *(GAS f32x4*)(zr + bj * HALF + n * 16) = acc[ai][bj][m][n] + x * DN_ALPHA; }
                if (m == 3) asm volatile("" ::: "memory"); }
    }
};
template <class Epi, class Sched, bool ALIGN_EPI = false, bool SP2 = false>
__device__ __forceinline__ void gemm_phase(PG8_LAS unsigned char* lds, const Gemm g, const Sched& S, const Epi& E) {
    int tid_ = threadIdx.x; asm volatile("" : "+v"(tid_));
    const int tid = tid_, wid = __builtin_amdgcn_readfirstlane(tid >> 6), lane = tid & 63, wr = wid >> 2, wc = wid & 3, fr = lane & 15, fq = lane >> 4;
    const int K = g.K, nt = K / BK;
    unsigned voffA[2], voffB[2];
#pragma unroll
    for (int i = 0; i < 2; ++i) { int R, C; stage_rc(tid * 16 + i * 8192, R, C); const int Rb = Epi::PERM ? ((R & ~31) + perm32(R & 31)) : R;
        voffA[i] = (unsigned)(R * g.lda + C) * 2u; voffB[i] = (unsigned)(Rb * K + C) * 2u; }
    const size_t kstep = (size_t)(BK * 2);
    const size_t hstepA = (size_t)HALF * g.lda * 2, hstepB = (size_t)HALF * K * 2;
    const size_t tstepA = 2 * hstepA, tstepB = 2 * hstepB;
    const unsigned ldsw = (unsigned)wid * 1024u;
    const int aoff = lds_byte(wr * 64 + fr, fq * 8), boff = lds_byte(wc * 32 + fr, fq * 8);
#define PG8_SA(b, h) (((b) * 2 + (h)) * HTB)
#define PG8_SB(b, h) ((4 + (b) * 2 + (h)) * HTB)
#define PG8_STAGE(bufoff, gbase, voff) do { _Pragma("unroll") for (int _i = 0; _i < 2; ++_i) \
        __builtin_amdgcn_global_load_lds((const unsigned*)((const char*)(gbase) + (voff)[_i]), (PG8_LAS unsigned*)(lds + (bufoff) + ldsw + _i * 8192), 16, 0, 0); } while (0)
#define PG8_LDA(dst, b, h) do { _Pragma("unroll") for (int m = 0; m < 4; ++m) _Pragma("unroll") for (int k = 0; k < 2; ++k) dst[m][k] = *(const PG8_LAS bf16x8*)(lds + PG8_SA(b, h) + aoff + m * 2048 + k * 1024); } while (0)
#define PG8_LDB(dst, b, h) do { _Pragma("unroll") for (int n = 0; n < 2; ++n) _Pragma("unroll") for (int k = 0; k < 2; ++k) dst[n][k] = *(const PG8_LAS bf16x8*)(lds + PG8_SB(b, h) + boff + n * 2048 + k * 1024); } while (0)
#define PG8_MMA(ai, bj, At, Bt) do { __builtin_amdgcn_s_setprio(1); _Pragma("unroll") for (int m = 0; m < 4; ++m) _Pragma("unroll") for (int n = 0; n < 2; ++n) _Pragma("unroll") for (int k = 0; k < 2; ++k) \
        acc[ai][bj][m][n] = __builtin_amdgcn_mfma_f32_16x16x32_bf16(Bt[n][k], At[m][k], acc[ai][bj][m][n], 0, 0, 0); __builtin_amdgcn_s_setprio(0); } while (0)
#define PG8_WAIT_V(n) asm volatile("s_waitcnt vmcnt(" #n ")" ::: "memory")
#define PG8_WAIT_L(n) asm volatile("s_waitcnt lgkmcnt(" #n ")" ::: "memory")
#define PG8_BAR __builtin_amdgcn_s_barrier()
#define PG8_SCHED __builtin_amdgcn_sched_barrier(0)
    Unit cur, nxt; int ui = 0;
    if (!S.next(0, cur)) return;
    f32x4 acc[2][2][4][2];
#pragma unroll
    for (int a = 0; a < 2; ++a)
#pragma unroll
        for (int b = 0; b < 2; ++b)
#pragma unroll
            for (int m = 0; m < 4; ++m)
#pragma unroll
                for (int n = 0; n < 2; ++n) acc[a][b][m][n] = (f32x4){0.f, 0.f, 0.f, 0.f};
    bf16x8 At[4][2], B0[2][2], B1[2][2];
    const char* cA = (const char*)g.A + (size_t)cur.pm * tstepA; const char* cB = (const char*)g.Bt + (size_t)cur.pn * tstepB;
    S.a_ready(cur);
    if constexpr (SP2) {
        PG8_STAGE(PG8_SB(0, 0), cB, voffB); PG8_STAGE(PG8_SB(0, 1), cB + hstepB, voffB); PG8_STAGE(PG8_SA(0, 0), cA, voffA); PG8_STAGE(PG8_SA(0, 1), cA + hstepA, voffA);
        if (wr == 1) PG8_BAR;
        PG8_WAIT_V(2); PG8_BAR;
        PG8_STAGE(PG8_SB(1, 0), cB + kstep, voffB); PG8_STAGE(PG8_SA(1, 0), cA + kstep, voffA); PG8_STAGE(PG8_SB(1, 1), cB + hstepB + kstep, voffB);
        PG8_WAIT_V(6); PG8_BAR;
    } else {
        PG8_STAGE(PG8_SB(0, 0), cB, voffB); PG8_STAGE(PG8_SA(0, 0), cA, voffA); PG8_STAGE(PG8_SB(0, 1), cB + hstepB, voffB); PG8_STAGE(PG8_SA(0, 1), cA + hstepA, voffA);
        if (wr == 1) PG8_BAR;
        PG8_WAIT_V(4); PG8_BAR;
        PG8_STAGE(PG8_SB(1, 0), cB + kstep, voffB); PG8_STAGE(PG8_SA(1, 0), cA + kstep, voffA); PG8_STAGE(PG8_SB(1, 1), cB + hstepB + kstep, voffB);
        PG8_WAIT_V(6); PG8_BAR;
    }
    for (;;) {
        const bool has_next = S.next(ui + 1, nxt);
        const char* nA = has_next ? (const char*)g.A + (size_t)nxt.pm * tstepA : cA; const char* nB = has_next ? (const char*)g.Bt + (size_t)nxt.pn * tstepB : cB;
        for (int t = 0; t < nt; t += 2) {
            const bool last = (t == nt - 2);
            const char* a1 = cA + (size_t)(t + 1) * kstep;
            const char* a2 = last ? nA : cA + (size_t)(t + 2) * kstep; const char* b2 = last ? nB : cB + (size_t)(t + 2) * kstep;
            const char* a3 = a2 + kstep; const char* b3 = b2 + kstep;
            if (last && has_next) S.a_ready(nxt);
            if constexpr (SP2) {
            PG8_LDB(B0, 0, 0); PG8_LDB(B1, 0, 1); PG8_SCHED; PG8_LDA(At, 0, 0); PG8_STAGE(PG8_SA(1, 1), a1 + hstepA, voffA);
            PG8_WAIT_V(8); PG8_WAIT_L(0); PG8_BAR; PG8_MMA(0, 0, At, B0); PG8_MMA(0, 1, At, B1); PG8_BAR; PG8_SCHED;
            PG8_LDA(At, 0, 1); PG8_STAGE(PG8_SB(0, 0), b2, voffB); PG8_STAGE(PG8_SB(0, 1), b2 + hstepB, voffB); PG8_STAGE(PG8_SA(0, 0), a2, voffA);
            PG8_WAIT_V(8); PG8_WAIT_L(0); PG8_BAR; PG8_MMA(1, 0, At, B0); PG8_MMA(1, 1, At, B1); PG8_BAR; PG8_SCHED;
            PG8_LDB(B0, 1, 0); PG8_LDB(B1, 1, 1); PG8_SCHED; PG8_LDA(At, 1, 0); PG8_STAGE(PG8_SA(0, 1), a2 + hstepA, voffA);
            PG8_WAIT_V(8); PG8_WAIT_L(0); PG8_BAR; PG8_MMA(0, 0, At, B0); PG8_MMA(0, 1, At, B1); PG8_BAR; PG8_SCHED;
            PG8_LDA(At, 1, 1); PG8_STAGE(PG8_SB(1, 0), b3, voffB); PG8_STAGE(PG8_SB(1, 1), b3 + hstepB, voffB); PG8_STAGE(PG8_SA(1, 0), a3, voffA);
            PG8_WAIT_V(8); PG8_WAIT_L(0); PG8_BAR; PG8_MMA(1, 0, At, B0); PG8_MMA(1, 1, At, B1); PG8_BAR; PG8_SCHED;
            } else {
            PG8_LDB(B0, 0, 0); PG8_SCHED; PG8_LDA(At, 0, 0); PG8_STAGE(PG8_SA(1, 1), a1 + hstepA, voffA);
            PG8_WAIT_L(8); PG8_BAR; PG8_WAIT_L(0); PG8_MMA(0, 0, At, B0); PG8_BAR; PG8_SCHED;
            PG8_LDB(B1, 0, 1); PG8_STAGE(PG8_SB(0, 0), b2, voffB);
            PG8_BAR; PG8_WAIT_L(0); PG8_MMA(0, 1, At, B1); PG8_BAR;
            PG8_LDA(At, 0, 1); PG8_STAGE(PG8_SA(0, 0), a2, voffA);
            PG8_BAR; PG8_WAIT_L(0); PG8_MMA(1, 0, At, B0); PG8_BAR; PG8_SCHED;
            PG8_STAGE(PG8_SB(0, 1), b2 + hstepB, voffB);
            PG8_WAIT_V(6); PG8_BAR; PG8_MMA(1, 1, At, B1); PG8_BAR;
            PG8_LDB(B0, 1, 0); PG8_SCHED; PG8_LDA(At, 1, 0); PG8_STAGE(PG8_SA(0, 1), a2 + hstepA, voffA);
            PG8_WAIT_L(8); PG8_BAR; PG8_WAIT_L(0); PG8_MMA(0, 0, At, B0); PG8_BAR; PG8_SCHED;
            PG8_LDB(B1, 1, 1); PG8_STAGE(PG8_SB(1, 0), b3, voffB);
            PG8_BAR; PG8_WAIT_L(0); PG8_MMA(0, 1, At, B1); PG8_BAR;
            PG8_LDA(At, 1, 1); PG8_STAGE(PG8_SA(1, 0), a3, voffA);
            PG8_BAR; PG8_WAIT_L(0); PG8_MMA(1, 0, At, B0); PG8_BAR; PG8_SCHED;
            PG8_STAGE(PG8_SB(1, 1), b3 + hstepB, voffB);
            PG8_WAIT_V(6); PG8_BAR; PG8_MMA(1, 1, At, B1); PG8_BAR;
            }
        }
        if constexpr (ALIGN_EPI) { if (wr == 0) PG8_BAR; }
        if constexpr (!Epi::AFTER_DRAIN) { E(acc, cur, wr, wc, fr, fq); S.done(cur); }
        if (!has_next) break;
#pragma unroll
        for (int a = 0; a < 2; ++a)
#pragma unroll
            for (int b = 0; b < 2; ++b)
#pragma unroll
                for (int m = 0; m < 4; ++m)
#pragma unroll
                    for (int n = 0; n < 2; ++n) acc[a][b][m][n] = (f32x4){0.f, 0.f, 0.f, 0.f};
        cur = nxt; cA = nA; cB = nB; ++ui;
        if constexpr (ALIGN_EPI) { if (wr == 1) PG8_BAR; }
    }
    PG8_WAIT_V(0);
    if constexpr (!ALIGN_EPI) { if (wr == 0) PG8_BAR; }
    PG8_BAR;
    if constexpr (Epi::AFTER_DRAIN) { E.fused(acc, cur, wr, wc, fr, fq, lds, wid, lane); S.done(cur); }
#undef PG8_SA
#undef PG8_SB
#undef PG8_STAGE
#undef PG8_LDA
#undef PG8_LDB
#undef PG8_MMA
#undef PG8_WAIT_V
#undef PG8_WAIT_L
#undef PG8_BAR
#undef PG8_SCHED
}
}

typedef GAS unsigned gu32;
#define XB_TMO      128
#define XB_XCNT(j)  (256  + 64 * (j))
#define XB_XSUB(j)  (1280 + 64 * (j))
#define XB_XGEN(j)  (2304 + 64 * (j))
#define XB_TOP      3328
#define XB_TOPGEN   3392
#define XCD_BAR_WORDS 3456
#define XB_SPIN_CAP (1u << 18)

__device__ __forceinline__ unsigned xb_ld(unsigned* p)              { return __hip_atomic_load(p, __ATOMIC_RELAXED, __HIP_MEMORY_SCOPE_AGENT); }
__device__ __forceinline__ unsigned xb_add(unsigned* p, unsigned v) { return __hip_atomic_fetch_add(p, v, __ATOMIC_RELAXED, __HIP_MEMORY_SCOPE_AGENT); }
__device__ __forceinline__ unsigned xb_xcc_id() { return (unsigned)__builtin_amdgcn_s_getreg((3 << 11) | 20) & 0xFu; }
#define XB_SPIN(cond, bar) do { unsigned _sp = 0; while (cond) { __builtin_amdgcn_s_sleep(1); \
    if ((++_sp & 255u) == 0u) { if (xb_ld(&(bar)[XB_TMO])) break; if (_sp > XB_SPIN_CAP) { atomicAdd(&(bar)[XB_TMO], 1u); break; } } } } while (0)

struct XcdBarrier {
    unsigned* bar; unsigned x;
    volatile LAS unsigned* st;
};

__device__ __forceinline__ XcdBarrier xcd_barrier_post(unsigned* bar, volatile LAS unsigned* st) {
    XcdBarrier b; b.bar = bar; b.x = xb_xcc_id(); b.st = st;
    if (threadIdx.x == 0) (void)xb_add(&bar[XB_XCNT(b.x)], 1u);
    return b;
}
__device__ __forceinline__ void xcd_barrier_complete(unsigned* bar, unsigned x, unsigned& nloc, unsigned& nx) {
    const unsigned G = gridDim.x * gridDim.y * gridDim.z;
    unsigned sum, cnt, mine, sp = 0u;
    for (;;) {
        sum = 0u; cnt = 0u; mine = 0u;
#pragma unroll
        for (unsigned j = 0; j < 16; ++j) { const unsigned c = xb_ld(&bar[XB_XCNT(j)]); sum += c; cnt += (c > 0u) ? 1u : 0u; mine = (j == x) ? c : mine; }
        if (sum == G) break;
        __builtin_amdgcn_s_sleep(1);
        if ((++sp & 255u) == 0u) { if (xb_ld(&bar[XB_TMO])) break; if (sp > XB_SPIN_CAP) { atomicAdd(&bar[XB_TMO], 1u); break; } }
    }
    nloc = mine > 0u ? mine : 1u; nx = cnt > 0u ? cnt : 1u;
}

__device__ __forceinline__ void xcd_barrier(const XcdBarrier& b) {
    asm volatile("s_waitcnt vmcnt(0)" ::: "memory");
    __syncthreads();
    if (threadIdx.x == 0) {
        unsigned* bar = b.bar; asm volatile("" : "+s"(bar));
        __builtin_amdgcn_s_waitcnt(0);
        unsigned nloc = b.st[0], nx = b.st[1];
        if (nloc == 0u) { xcd_barrier_complete(bar, b.x, nloc, nx); b.st[0] = nloc; b.st[1] = nx; }
        const unsigned old = xb_add(&bar[XB_XSUB(b.x)], 1u);
        const unsigned gen = old / nloc;
        if (old + 1u == (gen + 1u) * nloc) {
            __builtin_amdgcn_fence(__ATOMIC_RELEASE, "agent");
            asm volatile("s_waitcnt vmcnt(0)" ::: "memory");
            const unsigned og = xb_add(&bar[XB_TOP], 1u);
            const unsigned tg = og / nx;
            if (og + 1u == (tg + 1u) * nx) xb_add(&bar[XB_TOPGEN], 1u);
            else XB_SPIN(xb_ld(&bar[XB_TOPGEN]) == tg, bar);
            __builtin_amdgcn_fence(__ATOMIC_ACQUIRE, "agent");
            xb_add(&bar[XB_XGEN(b.x)], 1u);
            asm volatile("s_waitcnt vmcnt(0)" ::: "memory");
        } else {
            XB_SPIN(xb_ld(&bar[XB_XGEN(b.x)]) == gen, bar);
            __builtin_amdgcn_fence(__ATOMIC_ACQUIRE, "agent");
            asm volatile("s_waitcnt vmcnt(0)" ::: "memory");
        }
    }
    __syncthreads();
}


constexpr int NWAVES = 8;
struct Frame {
    LAS unsigned char* lds;
    int tid, lane, wave, vcu, G;
};
__device__ __forceinline__ float wave_sum(float v) {
#pragma unroll
    for (int o = 1; o < 64; o <<= 1) v += __shfl_xor(v, o);
    return v;
}
__device__ __forceinline__ void transpose_item(const float* W, int N, bf16* WT, int K, int dst_row0, int src_col0, int k0, LAS float* scr, int lane) {
#pragma unroll 8
    for (int i = 0; i < 32; ++i) { const int kk = 2 * i + (lane >> 5); scr[kk * 33 + (lane & 31)] = W[(size_t)(k0 + kk) * N + src_col0 + (lane & 31)]; }
    LDS_WAIT(); asm volatile("" ::: "memory");
    const int c = lane & 7;
#pragma unroll
    for (int j = 0; j < 4; ++j) { const int n = (lane >> 3) + 8 * j; const LAS float* s = scr + (8 * c) * 33 + n;
        u32x4 o; o.x = cvt_pk(s[0 * 33], s[1 * 33]); o.y = cvt_pk(s[2 * 33], s[3 * 33]); o.z = cvt_pk(s[4 * 33], s[5 * 33]); o.w = cvt_pk(s[6 * 33], s[7 * 33]);
        *(GAS u32x4*)(WT + (size_t)(dst_row0 + n) * K + k0 + 8 * c) = o; }
    LDS_WAIT(); asm volatile("" ::: "memory");
}
__device__ __forceinline__ int win_src_even(int n) {
    const int tile = n >> 8, p = n & 255, reg = tile >> 2, t = tile & 3;
    const int base = reg == 0 ? 3072 : reg == 1 ? 5120 : reg == 2 ? 0 : reg == 3 ? 1024 : reg == 4 ? 2048 : 4096;
    if (reg == 2 || reg == 3) { const int bj = p >> 7, j = p & 127; return base + (2 * t + (j >> 6)) * 128 + (j & 63) + 64 * bj; }
    return base + 256 * t + p;
}
__device__ __forceinline__ int win_src_odd(int n) {
    if (n >= 4096) return n;
    const int tile = n >> 8, p = n & 255, reg = tile >> 3, t = tile & 7, bj = p >> 7, j = p & 127;
    return reg * 2048 + (2 * t + (j >> 6)) * 128 + (j & 63) + 64 * bj;
}
template <bool ODD> __device__ __forceinline__ void conv_win(Frame& F, const float* W, bf16* WT) {
    LAS float* scr = (LAS float*)(F.lds + F.wave * 16384);
    int lane_o = F.lane; asm volatile("" : "+v"(lane_o));
    constexpr int N = ODD ? 8192 : 6144, NB = N / 32, NITEMS = 16 * NB;
    const int gw = F.vcu * NWAVES + F.wave, NGW = F.G * NWAVES;
    for (int it = gw; it < NITEMS; it += NGW) { const int kb = it / NB, nb = it % NB; const int src = ODD ? win_src_odd(32 * nb) : win_src_even(32 * nb);
        transpose_item(W, N, WT, 1024, 32 * nb, src, 64 * kb, scr, lane_o); }
}

__device__ __forceinline__ void sincos_d(float angf, float& s_out, float& c_out) {
    const double a = (double)angf; const double k = __builtin_rint(a * 0.63661977236758134308); const double r = (a - k * 1.57079632679489655800) - k * 6.12323399573676603587e-17;
    const double r2 = r * r;
    const double s = r * (1.0 + r2 * (-1.0 / 6 + r2 * (1.0 / 120 + r2 * (-1.0 / 5040 + r2 * (1.0 / 362880 + r2 * (-1.0 / 39916800 + r2 * (1.0 / 6227020800.0)))))));
    const double c = 1.0 + r2 * (-0.5 + r2 * (1.0 / 24 + r2 * (-1.0 / 720 + r2 * (1.0 / 40320 + r2 * (-1.0 / 3628800 + r2 * (1.0 / 479001600.0 + r2 * (-1.0 / 87178291200.0)))))));
    const int q = (int)((long long)k & 3);
    const double ss = (q == 0) ? s : (q == 1) ? c : (q == 2) ? -s : -c;
    const double cc = (q == 0) ? c : (q == 1) ? -s : (q == 2) ? -c : s;
    s_out = (float)ss; c_out = (float)cc;
}

struct Args { const float* in[23]; float* out; unsigned char* ws; int ph_lo, ph_hi; };

__device__ __forceinline__ void p0_prologue(Frame& F, const Args& A) {
    unsigned char* ws = A.ws;
    const int gw = F.vcu * NWAVES + F.wave, NGW = F.G * NWAVES, gt = gw * 64 + F.lane, NGT = NGW * 64;
    LAS float* scr = (LAS float*)(F.lds + F.wave * 16384);
    { const float* x = A.in[0]; bf16* x16 = (bf16*)(ws + WS_X16);
      for (size_t i = (size_t)gt; i < (size_t)MTOK * DM / 8; i += NGT) { const f32x4 a = *(const GAS f32x4*)(x + i * 8), b = *(const GAS f32x4*)(x + i * 8 + 4);
          u32x4 w; w.x = cvt_pk(a[0], a[1]); w.y = cvt_pk(a[2], a[3]); w.z = cvt_pk(b[0], b[1]); w.w = cvt_pk(b[2], b[3]); *(GAS u32x4*)(x16 + i * 8) = w; } }
    { float* COS = (float*)(ws + WS_ROPE); float* SIN = COS + SEQ * 64;
      for (int i = gt; i < SEQ * 64; i += NGT) { const int pos = i >> 6, f = i & 63;
          double w = 1.0; { double bpow = 0.86596432336006535; int e = f; while (e) { if (e & 1) w *= bpow; bpow *= bpow; e >>= 1; } }
          const float ang = (float)pos * (float)w; float s, c; sincos_d(ang, s, c); COS[i] = c; SIN[i] = s; } }
    if (gw < 2) { const int j = gw; const float* q1 = A.in[15] + j * 128, *k1 = A.in[16] + j * 128, *q2 = A.in[17] + j * 128, *k2 = A.in[18] + j * 128;
        float s1 = q1[F.lane] * k1[F.lane] + q1[F.lane + 64] * k1[F.lane + 64], s2 = q2[F.lane] * k2[F.lane] + q2[F.lane + 64] * k2[F.lane + 64];
        s1 = wave_sum(s1); s2 = wave_sum(s2);
        const float linit = (j == 0) ? 0.35550906759096927f : 0.55605820415654060f;
        if (F.lane == 0) { float* par = (float*)(ws + WS_PAR); par[j] = __expf(s1) - __expf(s2) + linit; } }
    conv_win<false>(F, A.in[1], (bf16*)(ws + WS_WIN));
    for (int it = gw; it < 4 * 1024; it += NGW) { const int l = it >> 10, r = it & 1023, kb = r >> 5, nb = r & 31;
        const float* W = (l & 1) ? A.in[20] + (size_t)(l >> 1) * 2048 * 1024 : A.in[11] + (size_t)(l >> 1) * 2048 * 1024;
        transpose_item(W, 1024, (bf16*)(ws + WS_WOUT) + (size_t)l * 2048 * 1024, 2048, 32 * nb, 32 * nb, 64 * kb, scr, F.lane); }
    for (int it = gw; it < 256; it += NGW) { const int mat = it >> 3, r = it & 7, kb = r >> 2, nb = r & 3;
        const int lj = mat >> 4, gate = (mat >> 3) & 1, blk = mat & 7; const float* W = A.in[gate ? 6 : 4] + ((size_t)lj * 8 + blk) * 128 * 128;
        transpose_item(W, 128, (bf16*)(ws + WS_WG) + (size_t)mat * 128 * 128, 128, 32 * nb, 32 * nb, 64 * kb, scr, F.lane); }
}

__device__ __forceinline__ void ln_phase(Frame& F, const float* Z, int ldz, const float* g, const float* bta, float* out, bf16* x16) {
    const int gw = F.vcu * NWAVES + F.wave, NGW = F.G * NWAVES;
    int lane_o = F.lane; asm volatile("" : "+v"(lane_o));
    f32x4 gv[4], bv[4];
#pragma unroll
    for (int j = 0; j < 4; ++j) { gv[j] = *(const GAS f32x4*)(g + 4 * lane_o + 256 * j); bv[j] = *(const GAS f32x4*)(bta + 4 * lane_o + 256 * j); }
    for (int m = gw; m < MTOK; m += NGW) {
        const GAS f32x4* zr = (const GAS f32x4*)(Z + (size_t)m * ldz) + lane_o;
        f32x4 v[4]; float s = 0.f;
#pragma unroll
        for (int j = 0; j < 4; ++j) { v[j] = zr[64 * j]; s += (v[j].x + v[j].y) + (v[j].z + v[j].w); }
        const float mean = wave_sum(s) * (1.f / DM); float s2 = 0.f;
#pragma unroll
        for (int j = 0; j < 4; ++j) { v[j] = v[j] - mean; s2 += (v[j].x * v[j].x + v[j].y * v[j].y) + (v[j].z * v[j].z + v[j].w * v[j].w); }
        const float rstd = 1.f / sqrtf(wave_sum(s2) * (1.f / DM) + NORM_EPS);
        GAS f32x4* o4 = (GAS f32x4*)(out + (size_t)m * DM) + lane_o; GAS u32x2* o2 = (GAS u32x2*)(x16 + (size_t)m * DM) + lane_o;
#pragma unroll
        for (int j = 0; j < 4; ++j) { const f32x4 y = v[j] * rstd * gv[j] + bv[j]; o4[64 * j] = y; u32x2 w; w.x = cvt_pk(y.x, y.y); w.y = cvt_pk(y.z, y.w); o2[64 * j] = w; }
    }
}

__device__ __forceinline__ void retention_unit(LAS unsigned char* lds, bf16* P, const float* gng, const float* gnb, int b, int h, bool st = true) {
    int tid_ = threadIdx.x; asm volatile("" : "+v"(tid_));
    const int tid = tid_, lane = tid & 63, wid = __builtin_amdgcn_readfirstlane(tid >> 6), r32 = lane & 31, hq = lane >> 5;
    const int ib = wid & 3, eh = wid >> 2;
    LAS unsigned char* QI = lds; LAS unsigned char* KI = lds + 32768; LAS unsigned char* VI = lds + 65536; LAS unsigned char* RI = lds + 98304;
    LAS float* ST = (LAS float*)(lds + LDS_X);
    LAS float* GN = (LAS float*)(lds + LDS_X + 2048);
    float lg; { const double x = 1.0 / (double)(1 << (5 + h)); double t = x, s = 0.0;
#pragma unroll
        for (int k = 1; k <= 10; ++k) { s += t / k; t *= x; } lg = (float)(-s * 1.4426950408889634); }
    const float g128 = __builtin_amdgcn_exp2f(128.f * lg);
    if (tid < 128) { GN[tid] = gng[h * 128 + tid]; GN[128 + tid] = gnb[h * 128 + tid]; }
    const unsigned rb0 = rr_base(lane, 0), rb1 = rr_base(lane, 1), tn0 = trn_base(lane, 0), tn1 = trn_base(lane, 1), tp0 = trp_base(lane, 0), tp1 = trp_base(lane, 1);
    f32x16 Racc[2]; Racc[0] = f32x16{}; Racc[1] = f32x16{};
    const int db = wid & 3, ebr = 2 * (wid >> 2);
    bf16* Pb = P + (size_t)b * SEQ * PP;
    u32x4 sq[4], sk[4], sv[4]; u32x2 sg[2][4];
    const unsigned voffS = (unsigned)(((tid >> 4) * PP + 8 * (tid & 15)) * 2);
    const unsigned voffG = (unsigned)((r32 * PP + 4 * hq) * 2);
#define RET_LOAD(nn) do { const GAS char* bs_ = (const GAS char*)(Pb + (size_t)(128 * (nn)) * PP + 128 * h); _Pragma("unroll") for (int k = 0; k < 4; ++k) { const GAS char* bk_ = bs_ + (size_t)k * 32 * PP * 2; \
        sq[k] = *(const GAS u32x4*)(bk_ + 4096 + voffS); sk[k] = *(const GAS u32x4*)(bk_ + 6144 + voffS); sv[k] = *(const GAS u32x4*)(bk_ + 8192 + voffS); } } while (0)
#define RET_LOADG(nn) do { const GAS char* bg_ = (const GAS char*)(Pb + (size_t)(128 * (nn) + 32 * ib) * PP + 128 * h + 64 * eh); _Pragma("unroll") for (int e2 = 0; e2 < 2; ++e2) _Pragma("unroll") for (int g4 = 0; g4 < 4; ++g4) sg[e2][g4] = *(const GAS u32x2*)(bg_ + (32 * e2 + 8 * g4) * 2 + voffG); } while (0)
    RET_LOAD(0); RET_LOADG(0);
    for (int n = 0; n < 16; ++n) {
        bf16* Pc = Pb + (size_t)(128 * n) * PP;
#pragma unroll
        for (int k = 0; k < 4; ++k) { const int id = tid + 512 * k, row = id >> 4, ch = id & 15;
            const u32x4 kk = sk[k];
            const float f = __builtin_amdgcn_exp2f(-(float)(row + 1) * lg);
            u32x4 kd; kd.x = cvt_pk(bf_lo(kk.x) * f, bf_hi(kk.x) * f); kd.y = cvt_pk(bf_lo(kk.y) * f, bf_hi(kk.y) * f); kd.z = cvt_pk(bf_lo(kk.z) * f, bf_hi(kk.z) * f); kd.w = cvt_pk(bf_lo(kk.w) * f, bf_hi(kk.w) * f);
            const unsigned o = off_a(row, ch);
            *(LAS u32x4*)(QI + o) = sq[k]; *(LAS u32x4*)(KI + o) = kd; *(LAS u32x4*)(VI + o) = sv[k];
            if (n == 0) *(LAS u32x4*)(RI + o) = (u32x4){0u, 0u, 0u, 0u}; }
        __syncthreads();
        bf16x8 qf[8];
#pragma unroll
        for (int s = 0; s < 8; ++s) qf[s] = *(const LAS bf16x8*)(QI + ib * 8192 + ((s & 1) ? rb1 : rb0) + 512 * (s >> 1));
        f32x16 acc[2]; acc[0] = f32x16{}; acc[1] = f32x16{};
#pragma unroll
        for (int ks = 0; ks < 8; ++ks)
#pragma unroll
            for (int e2 = 0; e2 < 2; ++e2) { const int c = 2 * eh + e2;
                const bf16x8 a = cat8(vtr(RI + tn0 + 4096 * ks + 512 * c), vtr(RI + tn1 + 4096 * ks + 512 * c));
                acc[e2] = __builtin_amdgcn_mfma_f32_32x32x16_bf16(a, qf[ks], acc[e2], 0, 0, 0); }
        for (int jb = 0; jb <= ib; ++jb) {
            f32x16 x = f32x16{};
#pragma unroll
            for (int ks = 0; ks < 8; ++ks) { const bf16x8 a = *(const LAS bf16x8*)(KI + jb * 8192 + ((ks & 1) ? rb1 : rb0) + 512 * (ks >> 1));
                x = __builtin_amdgcn_mfma_f32_32x32x16_bf16(a, qf[ks], x, 0, 0, 0); }
            if (jb == ib) {
#pragma unroll
                for (int r = 0; r < 16; ++r) if (crow(r, hq) > r32) x[r] = 0.f; }
            const bf16x8 xb0 = pack8f(x, 0), xb1 = pack8f(x, 8);
#pragma unroll
            for (int e2 = 0; e2 < 2; ++e2) { const int c = 2 * eh + e2;
                const bf16x8 a0 = cat8(vtr(VI + jb * 8192 + tp0 + 512 * c), vtr(VI + jb * 8192 + tp1 + 512 * c));
                const bf16x8 a1 = cat8(vtr(VI + jb * 8192 + tp0 + 4096 + 512 * c), vtr(VI + jb * 8192 + tp1 + 4096 + 512 * c));
                acc[e2] = __builtin_amdgcn_mfma_f32_32x32x16_bf16(a0, xb0, acc[e2], 0, 0, 0);
                acc[e2] = __builtin_amdgcn_mfma_f32_32x32x16_bf16(a1, xb1, acc[e2], 0, 0, 0); }
        }
        { const float sc = __builtin_amdgcn_exp2f((float)(32 * ib + r32 + 1) * lg); float s = 0.f, ss = 0.f;
#pragma unroll
          for (int e2 = 0; e2 < 2; ++e2)
#pragma unroll
              for (int r = 0; r < 16; ++r) { const float v = acc[e2][r] * sc; acc[e2][r] = v; s += v; ss += v * v; }
          s = swap32_sum(s); ss = swap32_sum(ss);
          if (hq == 0) { ST[(eh * 128 + 32 * ib + r32) * 2] = s; ST[(eh * 128 + 32 * ib + r32) * 2 + 1] = ss; } }
        if (n + 1 < 16) RET_LOAD(n + 1);
#pragma unroll
        for (int ks = 0; ks < 8; ++ks) { const bf16x8 bq = cat8(vtr(KI + tn0 + 4096 * ks + 512 * db), vtr(KI + tn1 + 4096 * ks + 512 * db));
#pragma unroll
            for (int e2 = 0; e2 < 2; ++e2) { const bf16x8 a = cat8(vtr(VI + tn0 + 4096 * ks + 512 * (ebr + e2)), vtr(VI + tn1 + 4096 * ks + 512 * (ebr + e2)));
                Racc[e2] = __builtin_amdgcn_mfma_f32_32x32x16_bf16(a, bq, Racc[e2], 0, 0, 0); } }
#pragma unroll
        for (int e2 = 0; e2 < 2; ++e2)
#pragma unroll
            for (int r = 0; r < 16; ++r) Racc[e2][r] *= g128;
        __syncthreads();
#pragma unroll
        for (int e2 = 0; e2 < 2; ++e2)
#pragma unroll
            for (int g4 = 0; g4 < 4; ++g4) { u32x2 w; w.x = cvt_pk(Racc[e2][4 * g4], Racc[e2][4 * g4 + 1]); w.y = cvt_pk(Racc[e2][4 * g4 + 2], Racc[e2][4 * g4 + 3]);
                *(LAS u32x2*)(RI + off_a(32 * db + r32, 4 * (ebr + e2) + g4) + 8 * hq) = w; }
        { const int i = 32 * ib + r32; const float s = ST[i * 2] + ST[(128 + i) * 2], ss = ST[i * 2 + 1] + ST[(128 + i) * 2 + 1];
          const float mean = s * (1.f / 128.f), var = fmaxf(ss * (1.f / 128.f) - mean * mean, 0.f), rstd = 1.f / sqrtf(var + NORM_EPS);
          GAS char* op = (GAS char*)(Pc + (size_t)(32 * ib) * PP + 128 * h + 64 * eh);
#pragma unroll
          for (int e2 = 0; e2 < 2; ++e2)
#pragma unroll
              for (int g4 = 0; g4 < 4; ++g4) { const int e0 = 64 * eh + 32 * e2 + 8 * g4 + 4 * hq; const f32x4 gg = *(const LAS f32x4*)(GN + e0), gb = *(const LAS f32x4*)(GN + 128 + e0);
                  const u32x2 gt = sg[e2][g4];
                  const float o0 = ((acc[e2][4 * g4 + 0] - mean) * rstd * gg[0] + gb[0]) * bf_lo(gt.x), o1 = ((acc[e2][4 * g4 + 1] - mean) * rstd * gg[1] + gb[1]) * bf_hi(gt.x);
                  const float o2 = ((acc[e2][4 * g4 + 2] - mean) * rstd * gg[2] + gb[2]) * bf_lo(gt.y), o3 = ((acc[e2][4 * g4 + 3] - mean) * rstd * gg[3] + gb[3]) * bf_hi(gt.y);
                  u32x2 w; w.x = cvt_pk(o0, o1); w.y = cvt_pk(o2, o3); if (st) *(GAS u32x2*)(op + (32 * e2 + 8 * g4) * 2 + voffG) = w; } }
        if (n + 1 < 16) RET_LOADG(n + 1);
    }
#undef RET_LOAD
#undef RET_LOADG
    __syncthreads();
}

__device__ __forceinline__ float softplus_f(float x) {
    if (x > 20.f) return x;
    const float y = __builtin_amdgcn_exp2f(x * LOG2E);
    if (y < 0.25f) { return y * (1.f + y * (-0.5f + y * (1.f / 3 + y * (-0.25f + y * (0.2f + y * (-1.f / 6 + y * (1.f / 7 + y * (-0.125f + y * (1.f / 9 + y * (-0.1f)))))))))); }
    return __builtin_amdgcn_logf(1.f + y) * 0.6931471805599453f;
}
__device__ __forceinline__ void lru_unit(LAS unsigned char* lds, bf16* P, const bf16* WG, const float* conv_w, const float* conv_b, const float* ba, const float* bx, const float* lam, int b, int g, bool st = true) {
    int tid_ = threadIdx.x; asm volatile("" : "+v"(tid_));
    const int tid = tid_, lane = tid & 63, wid = __builtin_amdgcn_readfirstlane(tid >> 6), r32 = lane & 31, hq = lane >> 5;
    const int tb = wid & 1, jb = wid >> 1;
    LAS unsigned char* XC = lds;
    LAS float* AF = (LAS float*)(lds + 16384);
    LAS float* UF = (LAS float*)(lds + 49152);
    LAS unsigned short* SGO = (LAS unsigned short*)(lds + 81920);
    LAS float* COMP = (LAS float*)(lds + 114688);
    LAS float* HC = (LAS float*)(lds + 118784);
    LAS float* CW = (LAS float*)(lds + 119808);
    for (int i = tid; i < 640; i += 512) { const int w = i >> 7, c = i & 127; CW[i] = (w < 4) ? conv_w[w * 1024 + 128 * g + c] : conv_b[128 * g + c]; }
    if (tid < 256) HC[tid] = 0.f;
    const unsigned rb0 = rr_base(lane, 0), rb1 = rr_base(lane, 1);
    bf16x8 waf[8], wxf[8];
    { const bf16* wa = WG + (size_t)g * 16384 + (size_t)(32 * jb + r32) * 128 + 8 * hq; const bf16* wx = wa + 8 * 16384;
#pragma unroll
      for (int ks = 0; ks < 8; ++ks) { waf[ks] = *(const GAS bf16x8*)(wa + 16 * ks); wxf[ks] = *(const GAS bf16x8*)(wx + 16 * ks); } }
    const int cj = 128 * g + 32 * jb + r32;
    const float kba = -LOG2E * ba[cj], kbx = -LOG2E * bx[cj], k1 = -8.f * LOG2E * softplus_f(-lam[cj]);
    bf16* Pb = P + (size_t)b * SEQ * PP;
    const int oct = tid & 15, tp = tid >> 4;
    const int sc_c = tid & 127, sc_seg = tid >> 7;
    const unsigned voffI = (unsigned)(((2 * tp) * PP + 128 * g + 8 * oct) * 2);
    const GAS char* Pbc = (const GAS char*)Pb;
    u32x4 xr[5], gr[2];
#pragma unroll
    for (int k = 0; k < 5; ++k) { const int t = 2 * tp - 3 + k; xr[k] = (t >= 0) ? *(const GAS u32x4*)(Pbc + (size_t)(k - 3) * PP * 2 + 10240 + voffI) : (u32x4){0u, 0u, 0u, 0u}; }
    gr[0] = *(const GAS u32x4*)(Pbc + 2048 + voffI); gr[1] = *(const GAS u32x4*)(Pbc + (size_t)PP * 2 + 2048 + voffI);
    __syncthreads();
    for (int n = 0; n < 32; ++n) {
        LAS unsigned short* SG = SGO + (n & 1) * 8192;
        { f32x4 o[2][2];
          { const f32x4 b0 = *(const LAS f32x4*)(CW + 512 + 8 * oct), b1 = *(const LAS f32x4*)(CW + 512 + 8 * oct + 4); o[0][0] = b0; o[0][1] = b1; o[1][0] = b0; o[1][1] = b1; }
#pragma unroll
          for (int w = 0; w < 4; ++w) { const f32x4 w0 = *(const LAS f32x4*)(CW + 128 * w + 8 * oct), w1 = *(const LAS f32x4*)(CW + 128 * w + 8 * oct + 4);
#pragma unroll
              for (int rr = 0; rr < 2; ++rr) { const u32x4 x = xr[rr + w];
                  o[rr][0] += w0 * (f32x4){bf_lo(x.x), bf_hi(x.x), bf_lo(x.y), bf_hi(x.y)}; o[rr][1] += w1 * (f32x4){bf_lo(x.z), bf_hi(x.z), bf_lo(x.w), bf_hi(x.w)}; } }
#pragma unroll
          for (int rr = 0; rr < 2; ++rr) { const int t = 2 * tp + rr;
              u32x4 w; w.x = cvt_pk(o[rr][0][0], o[rr][0][1]); w.y = cvt_pk(o[rr][0][2], o[rr][0][3]); w.z = cvt_pk(o[rr][1][0], o[rr][1][1]); w.w = cvt_pk(o[rr][1][2], o[rr][1][3]);
              *(LAS u32x4*)(XC + off_a(t, oct)) = w; *(LAS u32x4*)(SG + t * 128 + 8 * oct) = gr[rr]; }
          if (n + 1 < 32) { const GAS char* pn = Pbc + (size_t)(64 * (n + 1)) * PP * 2;
#pragma unroll
              for (int k = 0; k < 5; ++k) xr[k] = *(const GAS u32x4*)(pn + (long)(k - 3) * PP * 2 + 10240 + voffI);
              gr[0] = *(const GAS u32x4*)(pn + 2048 + voffI); gr[1] = *(const GAS u32x4*)(pn + (size_t)PP * 2 + 2048 + voffI); } }
        __syncthreads();
        if (n > 0 && st) { LAS unsigned short* SO = SGO + ((n - 1) & 1) * 8192; GAS char* po = (GAS char*)Pb + (size_t)(64 * (n - 1)) * PP * 2;
#pragma unroll
            for (int rr = 0; rr < 2; ++rr) *(GAS u32x4*)(po + (size_t)rr * PP * 2 + 2048 + voffI) = *(const LAS u32x4*)(SO + (2 * tp + rr) * 128 + 8 * oct); }
        { f32x16 ga = f32x16{}, gx = f32x16{};
#pragma unroll
          for (int ks = 0; ks < 8; ++ks) { const bf16x8 a = *(const LAS bf16x8*)(XC + tb * 8192 + ((ks & 1) ? rb1 : rb0) + 512 * (ks >> 1));
              ga = __builtin_amdgcn_mfma_f32_32x32x16_bf16(a, waf[ks], ga, 0, 0, 0); gx = __builtin_amdgcn_mfma_f32_32x32x16_bf16(a, wxf[ks], gx, 0, 0, 0); }
          const int c = 32 * jb + r32;
#pragma unroll
          for (int r = 0; r < 16; ++r) { const int t = 32 * tb + crow(r, hq);
              const float xc = __uint_as_float((unsigned)*(const LAS unsigned short*)(XC + off_a(t, c >> 3) + 2 * (c & 7)) << 16);
              const float rg = __builtin_amdgcn_rcpf(1.f + __builtin_amdgcn_exp2f(fmaf(ga[r], -LOG2E, kba))), ig = __builtin_amdgcn_rcpf(1.f + __builtin_amdgcn_exp2f(fmaf(gx[r], -LOG2E, kbx)));
              const float xl = rg * k1, a = __builtin_amdgcn_exp2f(xl), z = xl * 1.3862943611198906f;
              const float oms = -z * fmaf(z, fmaf(z, 1.f / 6, 0.5f), 1.f);
              const float om = (z > -0.06f) ? oms : fmaf(-a, a, 1.f);
              AF[t * 128 + c] = a; UF[t * 128 + c] = xc * ig * __builtin_amdgcn_sqrtf(om); } }
        __syncthreads();
        { float A = 1.f, B = 0.f;
#pragma unroll
          for (int t = 0; t < 16; ++t) { const float a = AF[(16 * sc_seg + t) * 128 + sc_c], u = UF[(16 * sc_seg + t) * 128 + sc_c]; B = a * B + u; A = a * A; }
          COMP[(sc_seg * 128 + sc_c) * 2] = A; COMP[(sc_seg * 128 + sc_c) * 2 + 1] = B; }
        __syncthreads();
        { float hv = HC[(n & 1) * 128 + sc_c];
          for (int s = 0; s < sc_seg; ++s) hv = COMP[(s * 128 + sc_c) * 2] * hv + COMP[(s * 128 + sc_c) * 2 + 1];
#pragma unroll
          for (int t = 0; t < 16; ++t) { const int tt = 16 * sc_seg + t; const float a = AF[tt * 128 + sc_c], u = UF[tt * 128 + sc_c]; hv = a * hv + u;
              const float o = hv * __uint_as_float((unsigned)SG[tt * 128 + sc_c] << 16); SG[tt * 128 + sc_c] = (unsigned short)(cvt_pk(o, 0.f) & 0xffffu); }
          if (sc_seg == 3) HC[((n + 1) & 1) * 128 + sc_c] = hv; }
    }
    __syncthreads();
    if (st) { LAS unsigned short* SO = SGO + 8192; GAS char* po = (GAS char*)Pb + (size_t)(64 * 31) * PP * 2;
#pragma unroll
        for (int rr = 0; rr < 2; ++rr) *(GAS u32x4*)(po + (size_t)rr * PP * 2 + 2048 + voffI) = *(const LAS u32x4*)(SO + (2 * tp + rr) * 128 + 8 * oct); }
    __syncthreads();
}

constexpr int AT_STAGE = 65536;
__device__ __forceinline__ void glds16(const GAS void* gsrc, unsigned lds_dst) { unsigned keep;
    asm volatile("s_mov_b32 %0, m0\n\ts_mov_b32 m0, %2\n\ts_nop 0\n\tglobal_load_lds_dwordx4 %1, off\n\ts_mov_b32 m0, %0" : "=&s"(keep) : "v"(gsrc), "s"(lds_dst) : "memory"); }
__device__ __forceinline__ void attn_issue(unsigned lds0, const bf16* Pb, int h, int hs, int NT, int wid, int lane) {
    const int s1 = (hs >> 1) + 1; if (s1 >= NT) return;
    const int isv = hs & 1, half = wid >> 2, jb0 = 4 * (wid & 3), buf = s1 & 1;
    const int col = isv ? 4096 + 256 * h + 128 * half : 2048 + (2 * h + half) * 128;
    const GAS char* src0 = (const GAS char*)(Pb + (size_t)(64 * s1) * PP + col);
    const unsigned dst0 = lds0 + (isv ? 65536 + buf * 32768 + half * 16384 : half * 32768 + buf * 16384) + jb0 * 1024;
#pragma unroll
    for (int k = 0; k < 4; ++k) { const int j = jb0 + k; const int rowp = 8 * (j >> 1) + ((lane >> 2) & 7), chg = 2 * (j & 1) + (lane >> 5), ch = 4 * chg + ((lane & 3) ^ ((rowp >> 2) & 3));
        glds16(src0 + (unsigned)((rowp * PP + 8 * ch) * 2), (unsigned)__builtin_amdgcn_readfirstlane(dst0 + k * 1024)); }
}
__device__ __forceinline__ void attn_qblock(LAS unsigned char* lds, bf16* P, const float* subg, float lamv, float omli, int b, int h, int qb, bool st = true) {
    int tid_ = threadIdx.x; asm volatile("" : "+v"(tid_));
    const int tid = tid_, lane = tid & 63, wid = __builtin_amdgcn_readfirstlane(tid >> 6), r32 = lane & 31, hq = lane >> 5;
    const int map = wid >> 2, wq = wid & 3;
    bf16* Pb = P + (size_t)b * SEQ * PP;
    const int rowpos = 128 * qb + 32 * wq + r32;
    bf16x8 qf[8];
    { const bf16* qp = Pb + (size_t)rowpos * PP + (2 * h + map) * 128 + 8 * hq;
#pragma unroll
      for (int s = 0; s < 8; ++s) qf[s] = *(const GAS bf16x8*)(qp + 16 * s); }
    const int NT = 2 * qb + 2;
    const unsigned rb0 = rr_base(lane, 0) + map * 32768, rb1 = rr_base(lane, 1) + map * 32768, tp0 = trp_base(lane, 0) + 65536, tp1 = trp_base(lane, 1) + 65536;
    f32x16 o[8];
#pragma unroll
    for (int c = 0; c < 8; ++c) o[c] = f32x16{};
    float m_run = -1e30f, l_run = 0.f;
    bf16x8 pb[4];
    const unsigned lds0 = (unsigned)(unsigned long)lds;
#define AT_QKSM(t) do { __builtin_amdgcn_sched_barrier(0); const LAS unsigned char* KB0_ = lds + ((t) & 1) * 16384 + rb0; const LAS unsigned char* KB1_ = lds + ((t) & 1) * 16384 + rb1; \
        asm volatile("" : "+v"(KB0_), "+v"(KB1_));     \
        f32x16 p0 = f32x16{}, p1 = f32x16{}; \
        _Pragma("unroll") for (int kh = 0; kh < 2; ++kh) { bf16x8 ka[4], kc[4]; \
            _Pragma("unroll") for (int k4 = 0; k4 < 4; ++k4) { const int ks = 4 * kh + k4; const LAS unsigned char* kp = ((ks & 1) ? KB1_ : KB0_) + 512 * (ks >> 1); ka[k4] = *(const LAS bf16x8*)(kp); kc[k4] = *(const LAS bf16x8*)(kp + 8192); } \
            _Pragma("unroll") for (int k4 = 0; k4 < 4; ++k4) { p0 = __builtin_amdgcn_mfma_f32_32x32x16_bf16(ka[k4], qf[4 * kh + k4], p0, 0, 0, 0); p1 = __builtin_amdgcn_mfma_f32_32x32x16_bf16(kc[k4], qf[4 * kh + k4], p1, 0, 0, 0); } } \
        __builtin_amdgcn_sched_group_barrier(0x100, 8, 0); \
        _Pragma("unroll") for (int i = 0; i < 8; ++i) { __builtin_amdgcn_sched_group_barrier(0x8, 1, 0); __builtin_amdgcn_sched_group_barrier(0x100, 1, 0); } \
        __builtin_amdgcn_sched_group_barrier(0x8, 8, 0); __builtin_amdgcn_sched_barrier(0); \
        if ((t) >= NT - 2) { const int kb = 64 * (t); const float NEG = -__builtin_inff(); \
            _Pragma("unroll") for (int r = 0; r < 16; ++r) { const int key = kb + crow(r, hq); if (key > rowpos) p0[r] = NEG; if (key + 32 > rowpos) p1[r] = NEG; } } \
        float pmax = p0[0]; \
        _Pragma("unroll") for (int r = 1; r < 16; ++r) pmax = fmaxf(pmax, p0[r]); \
        _Pragma("unroll") for (int r = 0; r < 16; ++r) pmax = fmaxf(pmax, p1[r]); \
        pmax = swap32_max(pmax); \
        if (!__all((pmax - m_run) * LOG2E <= 8.f)) { \
            const float mn = fmaxf(m_run, pmax), alpha = __builtin_amdgcn_exp2f((m_run - mn) * LOG2E); m_run = mn; l_run *= alpha; \
            _Pragma("unroll") for (int c = 0; c < 8; ++c) _Pragma("unroll") for (int r = 0; r < 16; ++r) o[c][r] *= alpha; } \
        { const float ml = -m_run * LOG2E; float ps = 0.f; \
          _Pragma("unroll") for (int r = 0; r < 16; ++r) { p0[r] = __builtin_amdgcn_exp2f(fmaf(p0[r], LOG2E, ml)); ps += p0[r]; } \
          _Pragma("unroll") for (int r = 0; r < 16; ++r) { p1[r] = __builtin_amdgcn_exp2f(fmaf(p1[r], LOG2E, ml)); ps += p1[r]; } \
          l_run += ps; } \
        pb[0] = pack8f(p0, 0); pb[1] = pack8f(p0, 8); pb[2] = pack8f(p1, 0); pb[3] = pack8f(p1, 8); \
        asm volatile("" : "+v"(pb[0]), "+v"(pb[1]), "+v"(pb[2]), "+v"(pb[3]), "+v"(l_run));     \
        } while (0)
#define AT_VO(i) ((((i) >> 2) >> 2) * 16384 + 512 * (((i) >> 2) & 3) + 4096 * ((i) & 3))
#define AT_VLD(i) cat8(vtr(VB0_ + AT_VO(i)), vtr(VB1_ + AT_VO(i)))
#define AT_PV(t) do { __builtin_amdgcn_sched_barrier(0); const LAS unsigned char* VB0_ = lds + ((t) & 1) * 32768 + tp0; const LAS unsigned char* VB1_ = lds + ((t) & 1) * 32768 + tp1; \
        asm volatile("" : "+v"(VB0_), "+v"(VB1_)); \
        bf16x8 vq[4]; _Pragma("unroll") for (int i = 0; i < 4; ++i) vq[i] = AT_VLD(i); \
        _Pragma("unroll") for (int i = 0; i < 32; ++i) {                                  \
            const bf16x8 vc = vq[i % 4]; if (i + 4 < 32) vq[i % 4] = AT_VLD(i + 4); \
            o[i >> 2] = __builtin_amdgcn_mfma_f32_32x32x16_bf16(vc, pb[i & 3], o[i >> 2], 0, 0, 0); } \
        _Pragma("unroll") for (int i = 0; i < 4; ++i) __builtin_amdgcn_sched_group_barrier(0x100, 2, 0);                   \
        _Pragma("unroll") for (int i = 0; i < 28; ++i) { __builtin_amdgcn_sched_group_barrier(0x8, 1, 0); __builtin_amdgcn_sched_group_barrier(0x100, 2, 0); }     \
        _Pragma("unroll") for (int i = 0; i < 4; ++i) __builtin_amdgcn_sched_group_barrier(0x8, 1, 0); \
        __builtin_amdgcn_sched_barrier(0); } while (0)
#define AT_WAIT(hs_) do { __builtin_amdgcn_sched_barrier(0); if (((hs_) >> 1) + 1 < NT) asm volatile("s_waitcnt vmcnt(4)" ::: "memory"); else asm volatile("s_waitcnt vmcnt(0)" ::: "memory"); __syncthreads(); } while (0)
    attn_issue(lds0, Pb, h, -2, NT + 1, wid, lane); attn_issue(lds0, Pb, h, -1, NT + 1, wid, lane);
    asm volatile("s_waitcnt vmcnt(4)" ::: "memory"); __syncthreads();
    if (map == 1) { attn_issue(lds0, Pb, h, 0, NT, wid, lane); AT_WAIT(0); }
    for (int t = 0; t < NT; ++t) {
        const int hs = 2 * t + map;
        attn_issue(lds0, Pb, h, hs, NT, wid, lane);
        AT_QKSM(t);
        AT_WAIT(hs);
        attn_issue(lds0, Pb, h, hs + 1, NT, wid, lane);
        AT_PV(t);
        AT_WAIT(hs + 1);
    }
    if (map == 0) { asm volatile("s_waitcnt vmcnt(0)" ::: "memory"); __syncthreads(); }
#undef AT_WAIT
#undef AT_QKSM
#undef AT_VO
#undef AT_PV
#undef AT_VLD
    { const float inv = 1.f / swap32_sum(l_run); const float f = (map == 1) ? inv * lamv : inv;
      LAS float* XB = (LAS float*)lds + (size_t)wq * 8 * 16 * 64 + lane;
      if (map == 1) {
#pragma unroll
          for (int c = 0; c < 8; ++c)
#pragma unroll
              for (int r = 0; r < 16; ++r) XB[(c * 16 + r) * 64] = o[c][r] * f; }
      __syncthreads();
      if (map == 0) { float ss = 0.f;
#pragma unroll
          for (int c = 0; c < 8; ++c)
#pragma unroll
              for (int r = 0; r < 16; ++r) { const float d = o[c][r] * f - XB[(c * 16 + r) * 64]; o[c][r] = d; ss += d * d; }
          ss = swap32_sum(ss); const float rs = omli / sqrtf(ss * (1.f / 256.f) + NORM_EPS);
          bf16* op = Pb + (size_t)rowpos * PP + 256 * h + 4 * hq;
#pragma unroll
          for (int c = 0; c < 8; ++c)
#pragma unroll
              for (int g4 = 0; g4 < 4; ++g4) { const f32x4 gg = *(const GAS f32x4*)(subg + 32 * c + 8 * g4 + 4 * hq);
                  u32x2 w; w.x = cvt_pk(o[c][4 * g4] * rs * gg[0], o[c][4 * g4 + 1] * rs * gg[1]); w.y = cvt_pk(o[c][4 * g4 + 2] * rs * gg[2], o[c][4 * g4 + 3] * rs * gg[3]);
                  if (st) *(GAS u32x2*)(op + 32 * c + 8 * g4) = w; } }
      __syncthreads(); }
}


#define IN(k) (lo <= (k) && (k) < hi)
#define SEAM(k) do { if (IN(k) && IN((k) + 1)) xcd_barrier(bar); } while (0)
template <int j> __device__ __forceinline__ void layer_pair(Frame& F, const Args& args, const int lo, const int hi, const XcdBarrier& bar) {
    unsigned char* ws; constexpr int LDZ = PP / 2;
        const int pb = 1 + 9 * j;
        { unsigned char* wsj = args.ws; asm volatile("" : "+s"(wsj)); ws = wsj; }
        int Gj = gridDim.x, bxj = blockIdx.x, vcuj = F.vcu; asm volatile("" : "+s"(Gj), "+s"(bxj), "+s"(vcuj)); F.G = Gj; F.vcu = vcuj;
        bf16* P = (bf16*)(ws + WS_P); bf16* X16 = (bf16*)(ws + WS_X16); bf16* WIN = (bf16*)(ws + WS_WIN);
        const float* COS = (const float*)(ws + WS_ROPE); const float* SIN = COS + SEQ * 64;
        float* Z = (float*)(ws + WS_P) + 1024;
        if (IN(pb + 0)) {
            pg8::Gemm g{X16, WIN, MTOK, 6144, 1024, 1024}; pg8::StaticOrder S; S.init(MTOK, 6144, F.G, bxj);
            pg8::EpiIn<false> E{P, COS, SIN};
#ifndef NO_E1
            pg8::gemm_phase<pg8::EpiIn<false>, pg8::StaticOrder, true, true>(F.lds, g, S, E);
#if PROBE_MASK & 1
            pg8::gemm_phase<pg8::EpiIn<false>, pg8::StaticOrder, true, true>(F.lds, g, S, E);
#endif
#endif
        } SEAM(pb + 0);
        if (IN(pb + 1)) {
#if PROBE_MASK & (2 | 32 | 64)
            { const bool dry = hi > 1000;
              for (int u = F.vcu; u < 256; u += F.G) {
                if ((PROBE_MASK & 64) && u < 128) continue;
                if ((PROBE_MASK & 32) && u >= 128) continue;
                if (u < 128) retention_unit(F.lds, P, args.in[9] + j * 1024, args.in[10] + j * 1024, u >> 3, u & 7, dry);
                else { const int v = u - 128; lru_unit(F.lds, P, (const bf16*)(ws + WS_WG) + (size_t)j * 2 * 8 * 16384, args.in[2] + j * 4096, args.in[3] + j * 1024,
                                                        args.in[5] + j * 1024, args.in[7] + j * 1024, args.in[8] + j * 1024, v >> 3, v & 7, dry); } }
              __syncthreads(); }
#endif
            for (int u = F.vcu; u < 256; u += F.G) {
#ifndef NO_RET
                if (u < 128) retention_unit(F.lds, P, args.in[9] + j * 1024, args.in[10] + j * 1024, u >> 3, u & 7);
#endif
#ifndef NO_LRU
                if (u >= 128) { const int v = u - 128; lru_unit(F.lds, P, (const bf16*)(ws + WS_WG) + (size_t)j * 2 * 8 * 16384, args.in[2] + j * 4096, args.in[3] + j * 1024,
                                                        args.in[5] + j * 1024, args.in[7] + j * 1024, args.in[8] + j * 1024, v >> 3, v & 7); }
#endif
            }
        } SEAM(pb + 1);
        if (IN(pb + 2)) {
            pg8::Gemm g{P, (const bf16*)(ws + WS_WOUT) + (size_t)(2 * j) * 2048 * 1024, MTOK, 1024, 2048, PP}; pg8::StaticOrder S; S.init(MTOK, 1024, F.G, bxj);
            pg8::EpiOut E{j == 0 ? args.in[0] : args.out, Z, LDZ};
#ifndef NO_E3
            pg8::gemm_phase<pg8::EpiOut, pg8::StaticOrder, true, true>(F.lds, g, S, E);
#if PROBE_MASK & 8
            pg8::gemm_phase<pg8::EpiOut, pg8::StaticOrder, true, true>(F.lds, g, S, E);
#endif
#endif
        } SEAM(pb + 2);
        if (IN(pb + 3)) {
#ifndef NO_LN
            ln_phase(F, Z, LDZ, args.in[12] + j * 1024, args.in[13] + j * 1024, args.out, X16);
#if PROBE_MASK & 16
            ln_phase(F, Z, LDZ, args.in[12] + j * 1024, args.in[13] + j * 1024, args.out, X16);
#endif
            conv_win<true>(F, args.in[14] + (size_t)j * 1024 * 8192, WIN);
#endif
        } SEAM(pb + 3);
        if (IN(pb + 4)) {
            pg8::Gemm g{X16, WIN, MTOK, 6144, 1024, 1024}; pg8::StaticOrder S; S.init(MTOK, 6144, F.G, bxj);
            pg8::EpiIn<true> E{P, COS, SIN};
#ifndef NO_O1
            pg8::gemm_phase<pg8::EpiIn<true>, pg8::StaticOrder, true, true>(F.lds, g, S, E);
#if PROBE_MASK & 1
            pg8::gemm_phase<pg8::EpiIn<true>, pg8::StaticOrder, true, true>(F.lds, g, S, E);
#endif
#endif
        } SEAM(pb + 4);
        if (IN(pb + 5)) {
            const float lamv = ((const float*)(ws + WS_PAR))[j]; const float omli = 1.f - ((j == 0) ? 0.35550906759096927f : 0.55605820415654060f);
#if PROBE_MASK & 4
            { const bool dry = hi > 1000;
              for (int it = F.vcu; it < 1024; it += F.G) { const int bh = it >> 3, x = it & 7;
                attn_qblock(F.lds, P, args.in[19] + j * 256, lamv, omli, bh >> 3, bh & 7, 15 - x, dry);
                attn_qblock(F.lds, P, args.in[19] + j * 256, lamv, omli, bh >> 3, bh & 7, x, dry); } }
#endif
            for (int it = F.vcu; it < 1024; it += F.G) { const int bh = it >> 3, x = it & 7;
#ifndef NO_ATT
                attn_qblock(F.lds, P, args.in[19] + j * 256, lamv, omli, bh >> 3, bh & 7, 15 - x);
                attn_qblock(F.lds, P, args.in[19] + j * 256, lamv, omli, bh >> 3, bh & 7, x);
#endif
            }
        } SEAM(pb + 5);
        if (IN(pb + 6)) {
            pg8::Gemm g{X16, WIN + (size_t)6144 * 1024, MTOK, 2048, 1024, 1024}; pg8::StaticOrder S; S.init(MTOK, 2048, F.G, bxj);
            pg8::EpiGate E{P};
#ifndef NO_O3
            pg8::gemm_phase<pg8::EpiGate, pg8::StaticOrder, true, true>(F.lds, g, S, E);
#endif
        } SEAM(pb + 6);
        if (IN(pb + 7)) {
            pg8::Gemm g{P, (const bf16*)(ws + WS_WOUT) + (size_t)(2 * j + 1) * 2048 * 1024, MTOK, 1024, 2048, PP}; pg8::StaticOrder S; S.init(MTOK, 1024, F.G, bxj);
            pg8::EpiOut E{args.out, Z, LDZ};
#ifndef NO_O4
            pg8::gemm_phase<pg8::EpiOut, pg8::StaticOrder, true, true>(F.lds, g, S, E);
#if PROBE_MASK & 8
            pg8::gemm_phase<pg8::EpiOut, pg8::StaticOrder, true, true>(F.lds, g, S, E);
#endif
#endif
        } SEAM(pb + 7);
        if (IN(pb + 8)) {
#ifndef NO_LN
            ln_phase(F, Z, LDZ, args.in[21] + j * 1024, args.in[22] + j * 1024, args.out, X16);
#if PROBE_MASK & 16
            ln_phase(F, Z, LDZ, args.in[21] + j * 1024, args.in[22] + j * 1024, args.out, X16);
#endif
            if (j == 0) conv_win<false>(F, args.in[1] + (size_t)1024 * 6144, WIN);
#endif
        } SEAM(pb + 8);
}
#undef IN
#undef SEAM
constexpr int N_PHASES = 19;
__global__ void __launch_bounds__(NWAVES * 64, 2) fwd_kernel(Args args) {
    extern __shared__ __attribute__((aligned(16))) unsigned char lds_raw[];
    Frame F;
    F.lds = (LAS unsigned char*)lds_raw;
    F.tid = threadIdx.x; F.lane = F.tid & 63; F.wave = __builtin_amdgcn_readfirstlane(F.tid >> 6);
    F.G = gridDim.x; { const int bx = blockIdx.x; F.vcu = (F.G % 8 == 0) ? (bx % 8) * (F.G / 8) + bx / 8 : bx; }
    unsigned char* ws = args.ws;
    gu32* ctl = (gu32*)(ws + WS_CTL);
    volatile LAS unsigned* MISC = (volatile LAS unsigned*)(F.lds + MISC_OFF);
    if (F.tid < 64) MISC[F.tid] = 0u;
    __syncthreads();
    const int lo = args.ph_lo, hi = args.ph_hi;
    XcdBarrier bar; bar.bar = (unsigned*)(ctl + CW_BAR); bar.x = 0; bar.st = nullptr;
    if (hi - lo > 1) bar = xcd_barrier_post((unsigned*)(ctl + CW_BAR), MISC + 8);
#define IN(k) (lo <= (k) && (k) < hi)
#define SEAM(k) do { if (IN(k) && IN((k) + 1)) xcd_barrier(bar); } while (0)
    constexpr int LDZ = PP / 2;

#ifndef NO_P0
    if (IN(0)) { p0_prologue(F, args); } SEAM(0);
#else
    SEAM(0);
#endif

    layer_pair<0>(F, args, lo, hi, bar);
    layer_pair<1>(F, args, lo, hi, bar);
#undef IN
#undef SEAM
}

extern "C" void kernel_launch(void* const* d_in, const int* in_sizes, int n_in, void* d_out, int out_size, void* d_ws, size_t ws_size, hipStream_t stream) {
    static int grid = 0;
    if (grid == 0) {
        if (n_in != 23 || in_sizes[0] != MTOK * DM || out_size != MTOK * DM || ws_size < WS_END) {
            fprintf(stderr, "kernel_launch: unexpected shapes (n_in %d, in0 %d, out %d, ws %zu < %zu); nothing launched\n", n_in, n_in > 0 ? in_sizes[0] : -1, out_size, ws_size, (size_t)WS_END); grid = -1; return; }
        int dev = 0, cus = 0, per_cu = 0;
        if (hipGetDevice(&dev) != hipSuccess || hipDeviceGetAttribute(&cus, hipDeviceAttributeMultiprocessorCount, dev) != hipSuccess) { grid = -1; return; }
        if (hipFuncSetAttribute((const void*)fwd_kernel, hipFuncAttributeMaxDynamicSharedMemorySize, LDS_BYTES) != hipSuccess) { fprintf(stderr, "kernel_launch: hipFuncSetAttribute failed\n"); grid = -1; return; }
        if (hipOccupancyMaxActiveBlocksPerMultiprocessor(&per_cu, (const void*)fwd_kernel, NWAVES * 64, LDS_BYTES) != hipSuccess || per_cu < 1)
            fprintf(stderr, "kernel_launch: note: occupancy query reports %d workgroups per CU\n", per_cu);
        (void)hipGetLastError();
        grid = cus;
    }
    if (grid < 0) return;
    (void)hipMemsetAsync((char*)d_ws + WS_CTL, 0, CTL_ZERO_BYTES, stream);
    Args a{};
    for (int i = 0; i < 23; ++i) a.in[i] = (const float*)d_in[i];
    a.out = (float*)d_out; a.ws = (unsigned char*)d_ws;
#if MK_SPLIT
    for (int p = 0; p < N_PHASES; ++p) { a.ph_lo = p; a.ph_hi = p + 1; hipLaunchKernelGGL(fwd_kernel, dim3(grid), dim3(NWAVES * 64), LDS_BYTES, stream, a); }
#else
    a.ph_lo = 0; a.ph_hi = N_PHASES;
    hipLaunchKernelGGL(fwd_kernel, dim3(grid), dim3(NWAVES * 64), LDS_BYTES, stream, a);
#endif
    const hipError_t le = hipPeekAtLastError();
    if (le != hipSuccess) fprintf(stderr, "kernel_launch: launch failed: %s\n", hipGetErrorName(le));
}
```
